# Optimizing an MI355X kernel written in HIP

```python
import math
import jax, jax.numpy as jnp
from jax import lax
import numpy as np

D_MODEL = 1024
BATCH = 32
SEQ = 256
DEPTH = 1
DEC_BATCH = 8
DEC_SEQ = 2048
PAST_LEN = 512

GRID_W = 64
MIX_WIDTH = D_MODEL
ATT_WIDTH = MIX_WIDTH // 2
N_DIFF_HEADS = 4
DIFF_HEAD_DIM = ATT_WIDTH // (2 * N_DIFF_HEADS)
VAL_DIM = 2 * DIFF_HEAD_DIM
MLP_WIDTH = MIX_WIDTH - ATT_WIDTH
N_SGU_GROUPS = 4
SGU_GROUP_DIM = MLP_WIDTH // N_SGU_GROUPS
CHUNK = 128
Q_BLOCK = 128
D_FF = -(-(8 * D_MODEL) // (3 * 256)) * 256
IN_WIDTH = 3 * ATT_WIDTH + 2 * MLP_WIDTH
ROPE_THETA = 10000.0
ROPE_AXIS_DIM = DIFF_HEAD_DIM // 2
EPS = 1e-6

kernel_name = "hybrid_diffattn_gmlp_prefix_dit_step"


def _rms(x, g):
    xf = x.astype(jnp.float32)
    y = xf * lax.rsqrt(jnp.mean(xf * xf, axis=-1, keepdims=True) + EPS)
    return (y * g.astype(jnp.float32)).astype(x.dtype)


def _rms_nogain(x):
    xf = x.astype(jnp.float32)
    y = xf * lax.rsqrt(jnp.mean(xf * xf, axis=-1, keepdims=True) + EPS)
    return y.astype(x.dtype)


def _axial_rope_tables(n):
    rows = n // GRID_W
    row = jnp.repeat(jnp.arange(rows), GRID_W).astype(jnp.float32)
    col = jnp.tile(jnp.arange(GRID_W), rows).astype(jnp.float32)
    inv = ROPE_THETA ** (-jnp.arange(0, ROPE_AXIS_DIM, 2, dtype=jnp.float32) / ROPE_AXIS_DIM)
    ang_r = row[:, None] * inv[None, :]
    ang_c = col[:, None] * inv[None, :]
    return (jnp.cos(ang_r), jnp.sin(ang_r), jnp.cos(ang_c), jnp.sin(ang_c))


def _rotate(a, cos, sin):
    half = a.shape[-1] // 2
    a1, a2 = a[..., :half], a[..., half:]
    cos = cos.astype(a.dtype)
    sin = sin.astype(a.dtype)
    return jnp.concatenate([a1 * cos - a2 * sin, a2 * cos + a1 * sin], axis=-1)


def _apply_axial_rope(x, tables):
    cos_r, sin_r, cos_c, sin_c = tables
    xr, xc = x[..., :ROPE_AXIS_DIM], x[..., ROPE_AXIS_DIM:]
    return jnp.concatenate([_rotate(xr, cos_r, sin_r), _rotate(xc, cos_c, sin_c)], axis=-1)


def _project(xm, w_in, q_g, k_g):
    B, S, _ = xm.shape
    h = xm @ w_in
    q, k, v, u, gv = jnp.split(
        h, [ATT_WIDTH, 2 * ATT_WIDTH, 3 * ATT_WIDTH, 3 * ATT_WIDTH + MLP_WIDTH], axis=-1)
    q = _rms(q.reshape(B, S, N_DIFF_HEADS, 2, DIFF_HEAD_DIM), q_g).transpose(0, 2, 3, 1, 4)
    k = _rms(k.reshape(B, S, N_DIFF_HEADS, 2, DIFF_HEAD_DIM), k_g).transpose(0, 2, 3, 1, 4)
    v = v.reshape(B, S, N_DIFF_HEADS, VAL_DIM).transpose(0, 2, 1, 3)
    return q, k, v, u, gv


def _diff_attention(q, k, v, lam):
    B, H, _, Nq, DH = q.shape
    nb = Nq // Q_BLOCK
    scale = 1.0 / math.sqrt(DH)
    qb = jnp.moveaxis(q.reshape(B, H, 2, nb, Q_BLOCK, DH), 3, 0)

    def block(qblk):
        s = jnp.einsum('bhiqd,bhikd->bhiqk', qblk, k).astype(jnp.float32) * scale
        p = jax.nn.softmax(s, axis=-1)
        a = p[:, :, 0] - lam * p[:, :, 1]
        return jnp.einsum('bhqk,bhkd->bhqd', a.astype(v.dtype), v)

    out = lax.map(block, qb)
    return jnp.moveaxis(out, 0, 2).reshape(B, H, Nq, VAL_DIM)


def _diff_out(o, lambda_init, att_out_g):
    B, H, S, _ = o.shape
    o = _rms_nogain(o) * (1.0 - lambda_init)
    return o.transpose(0, 2, 1, 3).reshape(B, S, ATT_WIDTH) * att_out_g


def _chunk_mlp(u, gv, sgu_norm_g, sgu_w, sgu_b, mlp_out_g):
    B, S, _ = u.shape
    n = S // CHUNK
    gv = _rms(gv.reshape(B, n, CHUNK, N_SGU_GROUPS, SGU_GROUP_DIM),
              sgu_norm_g.reshape(N_SGU_GROUPS, SGU_GROUP_DIM))
    s = jnp.einsum('gpq,bnqgc->bnpgc', sgu_w, gv) + sgu_b.T[:, :, None]
    out = (u.reshape(B, n, CHUNK, N_SGU_GROUPS, SGU_GROUP_DIM) * s).reshape(B, S, MLP_WIDTH)
    return _rms(out, mlp_out_g)


def _layer(x, cond, k_ctx, v_ctx, lp, lambda_init, rope):
    (norm1_g, norm2_g, w_ada, b_ada, w_in, q_norm_g, k_norm_g, lambda_q1, lambda_k1,
     lambda_q2, lambda_k2, att_out_g, sgu_norm_g, sgu_w, sgu_b, mlp_out_g, w_out,
     w_ffn_in, w_ffn_out) = lp
    mods = jax.nn.silu(cond) @ w_ada + b_ada
    shift1, scale1, gate1, shift2, scale2, gate2 = [m[:, None, :] for m in jnp.split(mods, 6, axis=-1)]

    xm = _rms(x, norm1_g) * (1.0 + scale1) + shift1
    q, k, v, u, gv = _project(xm, w_in, q_norm_g, k_norm_g)
    if rope is None:
        k_ctx, v_ctx = k, v
        k_all, v_all = k, v
    else:
        q = _apply_axial_rope(q, rope)
        k = _apply_axial_rope(k, rope)
        k_all = jnp.concatenate([k, k_ctx.astype(k.dtype)], axis=3)
        v_all = jnp.concatenate([v, v_ctx.astype(v.dtype)], axis=2)
    lam = (jnp.exp(jnp.sum(lambda_q1.astype(jnp.float32) * lambda_k1.astype(jnp.float32)))
           - jnp.exp(jnp.sum(lambda_q2.astype(jnp.float32) * lambda_k2.astype(jnp.float32)))
           + lambda_init)
    att = _diff_out(_diff_attention(q, k_all, v_all, lam), lambda_init, att_out_g)
    mlp = _chunk_mlp(u, gv, sgu_norm_g, sgu_w, sgu_b, mlp_out_g)
    x = x + gate1 * (jnp.concatenate([att, mlp], axis=-1) @ w_out)

    xm2 = _rms(x, norm2_g) * (1.0 + scale2) + shift2
    g, up = jnp.split(xm2 @ w_ffn_in, 2, axis=-1)
    x = x + gate2 * ((jax.nn.silu(g) * up) @ w_ffn_out)
    return x, k_ctx, v_ctx


def setup_inputs(seed: int = 0) -> dict:
    key = jax.random.key(seed)
    ks = jax.random.split(key, 26)
    f32 = jnp.float32

    def nrm(k, shape, scale):
        return jax.random.normal(k, shape, f32) * scale

    return {
        "x_prompt": nrm(ks[0], (BATCH, SEQ, D_MODEL), 1.0),
        "x_sample": nrm(ks[1], (DEC_BATCH, DEC_SEQ, D_MODEL), 1.0),
        "cache_k_ctx": nrm(ks[2], (DEC_BATCH, DEPTH, N_DIFF_HEADS, 2, PAST_LEN, DIFF_HEAD_DIM), 1.0),
        "cache_v_ctx": nrm(ks[3], (DEC_BATCH, DEPTH, N_DIFF_HEADS, PAST_LEN, VAL_DIM), 1.0),
        "c": nrm(ks[4], (DEC_BATCH, D_MODEL), 1.0),
        "c_ctx": nrm(ks[5], (D_MODEL,), 1.0),
        "norm1_g": 1.0 + nrm(ks[6], (DEPTH, D_MODEL), 0.02),
        "norm2_g": 1.0 + nrm(ks[7], (DEPTH, D_MODEL), 0.02),
        "w_ada": nrm(ks[8], (DEPTH, D_MODEL, 6 * D_MODEL), D_MODEL ** -0.5),
        "b_ada": nrm(ks[9], (DEPTH, 6 * D_MODEL), 0.02),
        "w_in": nrm(ks[10], (DEPTH, D_MODEL, IN_WIDTH), D_MODEL ** -0.5),
        "q_norm_g": 1.0 + nrm(ks[11], (DEPTH, DIFF_HEAD_DIM), 0.02),
        "k_norm_g": 1.0 + nrm(ks[12], (DEPTH, DIFF_HEAD_DIM), 0.02),
        "lambda_q1": nrm(ks[13], (DEPTH, DIFF_HEAD_DIM), 0.1),
        "lambda_k1": nrm(ks[14], (DEPTH, DIFF_HEAD_DIM), 0.1),
        "lambda_q2": nrm(ks[15], (DEPTH, DIFF_HEAD_DIM), 0.1),
        "lambda_k2": nrm(ks[16], (DEPTH, DIFF_HEAD_DIM), 0.1),
        "att_out_g": 1.0 + nrm(ks[17], (DEPTH, ATT_WIDTH), 0.02),
        "sgu_norm_g": 1.0 + nrm(ks[18], (DEPTH, MLP_WIDTH), 0.02),
        "sgu_w": nrm(ks[19], (DEPTH, N_SGU_GROUPS, CHUNK, CHUNK), CHUNK ** -0.5),
        "sgu_b": 1.0 + nrm(ks[20], (DEPTH, N_SGU_GROUPS, CHUNK), 0.02),
        "mlp_out_g": 1.0 + nrm(ks[21], (DEPTH, MLP_WIDTH), 0.02),
        "w_out": nrm(ks[22], (DEPTH, MIX_WIDTH, D_MODEL), MIX_WIDTH ** -0.5),
        "w_ffn_in": nrm(ks[23], (DEPTH, D_MODEL, 2 * D_FF), D_MODEL ** -0.5),
        "w_ffn_out": nrm(ks[24], (DEPTH, D_FF, D_MODEL), D_FF ** -0.5),
    }


def reference(x_prompt, x_sample, cache_k_ctx, cache_v_ctx, c, c_ctx, norm1_g, norm2_g,
              w_ada, b_ada, w_in, q_norm_g, k_norm_g, lambda_q1, lambda_k1, lambda_q2,
              lambda_k2, att_out_g, sgu_norm_g, sgu_w, sgu_b, mlp_out_g, w_out,
              w_ffn_in, w_ffn_out):
    rope = _axial_rope_tables(x_sample.shape[1])
    xp, xs = x_prompt, x_sample
    k_states, v_states = [], []
    for l in range(DEPTH):
        lp = (norm1_g[l], norm2_g[l], w_ada[l], b_ada[l], w_in[l], q_norm_g[l], k_norm_g[l],
              lambda_q1[l], lambda_k1[l], lambda_q2[l], lambda_k2[l], att_out_g[l],
              sgu_norm_g[l], sgu_w[l], sgu_b[l], mlp_out_g[l], w_out[l], w_ffn_in[l],
              w_ffn_out[l])
        lambda_init = 0.8 - 0.6 * math.exp(-0.3 * l)
        xp, k_c, v_c = _layer(xp, c_ctx[None, :], None, None, lp, lambda_init, None)
        k_states.append(k_c)
        v_states.append(v_c)
        xs, _, _ = _layer(xs, c, cache_k_ctx[:, l], cache_v_ctx[:, l], lp, lambda_init, rope)
    state_k_ctx = jnp.stack(k_states, axis=1)
    state_v_ctx = jnp.stack(v_states, axis=1)
    return (xp, xs, state_k_ctx, state_v_ctx)
```

```cpp
#include <hip/hip_runtime.h>
#include <hip/hip_cooperative_groups.h>
#include <cstdio>
#include <cstdint>
namespace cg = cooperative_groups;

#ifndef MK_N_LAUNCHES
#define MK_N_LAUNCHES 1
#endif

typedef unsigned short bf16;
constexpr int NTOK = 24576, NPROMPT = 8192, DM = 1024, DFF = 2816, NIN = 2560;
constexpr size_t MiB = 1u << 20;
constexpr size_t WS_MODS = 0, WS_ROPEC = 256 * 1024, WS_ROPES = 260 * 1024, WS_SSQ = 512 * 1024;
constexpr size_t WS_W1T = 1 * MiB, WS_W2T = 6 * MiB, WS_W3T = 8 * MiB, WS_W4T = 19 * MiB;
constexpr size_t WS_XM = 25 * MiB;
constexpr size_t WS_A = 73 * MiB;
constexpr size_t WS_QP = WS_A, WS_QS = WS_A + 8 * MiB, WS_KP = WS_A + 24 * MiB, WS_KS = WS_A + 32 * MiB;
constexpr size_t WS_VTP = WS_A + 52 * MiB, WS_VTS = WS_A + 60 * MiB, WS_U = WS_A + 80 * MiB, WS_GVTP = WS_A + 104 * MiB, WS_GVTS = WS_A + 112 * MiB;
constexpr size_t WS_HID = WS_A, WS_END = WS_A + 132 * MiB;
static_assert(WS_GVTS + 16 * MiB <= WS_END && WS_END <= 256 * MiB, "workspace map");
constexpr size_t OUT_Y = 0, OUT_STK = (size_t)NTOK * DM, OUT_STV = OUT_STK + 4194304;

namespace pg8 {
#define PG8_LAS __attribute__((address_space(3)))
typedef unsigned short bf16_t;
typedef short bf16x8 __attribute__((ext_vector_type(8)));
typedef float f32x4 __attribute__((ext_vector_type(4)));
typedef unsigned u32x4 __attribute__((ext_vector_type(4)));
constexpr int BM = 256, BK = 64, HALF = 128, HTB = HALF * BK * 2  , STAGE_BYTES = 8 * HTB, NXCD = 8, WGM = 8;

__host__ __device__ __forceinline__ int lds_byte(int r, int c) { const int st = (r >> 4) * 2 + (c >> 5), rr = r & 15, cc = c & 31, ob = rr * 64 + cc * 2; return st * 1024 + (ob ^ (((ob >> 9) & 1) << 5)); }
__host__ __device__ __forceinline__ void stage_rc(int b, int& R, int& C) { const int st = b / 1024, sb = b % 1024, swz = sb ^ (((sb >> 9) & 1) << 5); R = (st >> 1) * 16 + swz / 64; C = (st & 1) * 32 + (swz % 64) / 2; }
__host__ __device__ __forceinline__ int perm32(int rho) { const int n = rho >> 4, i = rho & 15; return 8 * (i >> 2) + 4 * n + (i & 3); }

struct Unit { int pm, pn; };
struct Gemm { const bf16_t* A; const bf16_t* Bt; int M, N, K; };

struct StaticOrder {
    int nM, nN, nwg, G, c;
    __host__ __device__ void init(int M, int N, int G_, int c_) { nM = M / BM; nN = N / BM; nwg = nM * nN; G = G_; c = c_; }
    __host__ __device__ bool next(int i, Unit& u) const {
        const long L = (long)i * G + c; if (L >= nwg) return false;
        int wgid = (int)L; { const int q = nwg / NXCD, r = nwg % NXCD, xcd = wgid % NXCD, off = wgid / NXCD; wgid = (xcd < r ? xcd * (q + 1) : r * (q + 1) + (xcd - r) * q) + off; }
        const int nig = WGM * nN, gid = wgid / nig, fm = gid * WGM, gsz = (nM - fm) < WGM ? (nM - fm) : WGM;
        u.pm = fm + ((wgid % nig) % gsz); u.pn = (wgid % nig) / gsz; return true;
    }
    __device__ __forceinline__ void a_ready(const Unit&) const {}
    __device__ __forceinline__ void done(const Unit&) const {}
};

__device__ __forceinline__ unsigned cvt_pk_bf16(float lo, float hi) { unsigned r; asm volatile("v_cvt_pk_bf16_f32 %0, %1, %2" : "=v"(r) : "v"(lo), "v"(hi)); return r; }
typedef float f32x2 __attribute__((ext_vector_type(2)));
typedef unsigned u32x2 __attribute__((ext_vector_type(2)));
__device__ __forceinline__ u32x2 pack4(const f32x4 v) { u32x2 w; w.x = cvt_pk_bf16(v[0], v[1]); w.y = cvt_pk_bf16(v[2], v[3]); return w; }
__device__ __forceinline__ bf16_t bf1(float v) { return (bf16_t)(cvt_pk_bf16(v, 0.f) & 0xffffu); }

struct EpiIn {
    static constexpr bool PERM = false, AFTER_DRAIN = false;
    unsigned char* ws; float* out; const float *qg, *kg;
    __device__ __forceinline__ void operator()(const f32x4 (&acc)[2][2][4][2], const Unit& u, int wr, int wc, int fr, int fq) const {
        asm volatile("" : "+v"(fr), "+v"(fq));
        const int pm = u.pm, pn = u.pn;
        const bool prompt = pm < 32;
        const int b = prompt ? pm : ((pm - 32) >> 3);
        const int s0 = prompt ? 0 : (((pm - 32) & 7) << 8);
        const int kind = pn >> 1;
        const int chw = ((pn & 1) << 8) + (wc << 6);
        if (kind <= 1) {
            const int hm = chw >> 6;
            const float* gain = kind == 0 ? qg : kg;
            f32x4 g4[2][2];
#pragma unroll
            for (int bj = 0; bj < 2; ++bj)
#pragma unroll
                for (int n = 0; n < 2; ++n) g4[bj][n] = *(const f32x4*)(gain + 32 * bj + 16 * n + 4 * fq);
            const int Sx = prompt ? 256 : (kind == 0 ? 2048 : 2560);
            bf16_t* dst = (bf16_t*)(ws + (kind == 0 ? (prompt ? WS_QP : WS_QS) : (prompt ? WS_KP : WS_KS))) + ((size_t)(b * 8 + hm) * Sx + s0) * 64 + 4 * fq;
            float* dstK = out + OUT_STK + ((size_t)(b * 8 + hm) * 256) * 64 + 4 * fq;
#pragma unroll
            for (int ai = 0; ai < 2; ++ai)
#pragma unroll
                for (int m = 0; m < 4; ++m) {
                    const int rl = ai * 128 + wr * 64 + m * 16 + fr;
                    f32x4 v[2][2]; float ss = 0.f;
#pragma unroll
                    for (int bj = 0; bj < 2; ++bj)
#pragma unroll
                        for (int n = 0; n < 2; ++n) { v[bj][n] = acc[ai][bj][m][n]; const f32x4 q = v[bj][n] * v[bj][n]; ss += (q[0] + q[1]) + (q[2] + q[3]); }
                    ss += __shfl_xor(ss, 16); ss += __shfl_xor(ss, 32);
                    const float rstd = rsqrtf(ss * (1.0f / 64.0f) + 1e-6f);
#pragma unroll
                    for (int bj = 0; bj < 2; ++bj)
#pragma unroll
                        for (int n = 0; n < 2; ++n) v[bj][n] = v[bj][n] * rstd * g4[bj][n];
                    if (!prompt) {
                        const int gr = (s0 >> 6) + 2 * ai + wr, gc = 16 * m + fr;
#pragma unroll
                        for (int bj = 0; bj < 2; ++bj) {
                            const int pos = bj == 0 ? gr : gc;
                            const f32x4 c4 = *(const f32x4*)((const float*)(ws + WS_ROPEC) + pos * 16 + 4 * fq), s4 = *(const f32x4*)((const float*)(ws + WS_ROPES) + pos * 16 + 4 * fq);
                            const f32x4 a1 = v[bj][0], a2 = v[bj][1];
                            v[bj][0] = a1 * c4 - a2 * s4; v[bj][1] = a2 * c4 + a1 * s4;
                        }
                    }
#pragma unroll
                    for (int bj = 0; bj < 2; ++bj)
#pragma unroll
                        for (int n = 0; n < 2; ++n) *(u32x2*)(dst + (size_t)rl * 64 + 32 * bj + 16 * n) = pack4(v[bj][n]);
                    if (prompt && kind == 1) {
#pragma unroll
                        for (int bj = 0; bj < 2; ++bj)
#pragma unroll
                            for (int n = 0; n < 2; ++n) *(f32x4*)(dstK + (size_t)rl * 64 + 32 * bj + 16 * n) = v[bj][n];
                    }
                    asm volatile("" ::: "memory");
                }
        } else if (kind == 3) {
            bf16_t* dst = (bf16_t*)(ws + WS_U) + (size_t)(pm * 256) * 512 + chw + 4 * fq;
#pragma unroll
            for (int ai = 0; ai < 2; ++ai)
#pragma unroll
                for (int m = 0; m < 4; ++m) {
                    const int rl = ai * 128 + wr * 64 + m * 16 + fr;
#pragma unroll
                    for (int bj = 0; bj < 2; ++bj)
#pragma unroll
                        for (int n = 0; n < 2; ++n) *(u32x2*)(dst + (size_t)rl * 512 + 32 * bj + 16 * n) = pack4(acc[ai][bj][m][n]);
                    asm volatile("" ::: "memory");
                }
        } else {
            const int Sx = prompt ? 256 : (kind == 2 ? 2560 : 2048);
            bf16_t* dst = (bf16_t*)(ws + (kind == 2 ? (prompt ? WS_VTP : WS_VTS) : (prompt ? WS_GVTP : WS_GVTS))) + ((size_t)b * 512 + chw) * Sx + s0;
            float* dstV = out + OUT_STV + ((size_t)(b * 4 + (chw >> 7)) * 256) * 128 + (chw & 127);
            float* dq = (float*)(ws + WS_SSQ) + (size_t)(pm * 256) * 4 + (chw >> 7);
            const unsigned lo = (unsigned)(4 * fq) * (unsigned)Sx + (unsigned)(wr * 64 + fr);
#pragma unroll
            for (int ai = 0; ai < 2; ++ai)
#pragma unroll
                for (int m = 0; m < 4; ++m) {
                    const int rl = ai * 128 + wr * 64 + m * 16 + fr;
                    float ss = 0.f;
#pragma unroll
                    for (int bj = 0; bj < 2; ++bj)
#pragma unroll
                        for (int n = 0; n < 2; ++n) {
                            const f32x4 v = acc[ai][bj][m][n]; const int co = 32 * bj + 16 * n;
                            bf16_t* dc = dst + (size_t)co * Sx + (ai * 128 + m * 16);
#pragma unroll
                            for (int j = 0; j < 4; ++j) dc[lo + (unsigned)j * (unsigned)Sx] = bf1(v[j]);
                            if (kind == 2 && prompt) *(f32x4*)(dstV + (size_t)rl * 128 + co + 4 * fq) = v;
                            const f32x4 q = v * v; ss += (q[0] + q[1]) + (q[2] + q[3]);
                        }
                    if (kind == 4) {
                        ss += __shfl_xor(ss, 16); ss += __shfl_xor(ss, 32);
                        if (fq == 0) atomicAdd(dq + (size_t)rl * 4, ss);
                    }
                    asm volatile("" ::: "memory");
                }
        }
    }
};

struct EpiRes {
    static constexpr bool PERM = false, AFTER_DRAIN = false;
    const float *base_p, *base_s; float* out; const float* gate;
    __device__ __forceinline__ void operator()(const f32x4 (&acc)[2][2][4][2], const Unit& u, int wr, int wc, int fr, int fq) const {
        asm volatile("" : "+v"(fr), "+v"(fq));
        const int pm = u.pm, cond = pm < 32 ? 0 : 1 + ((pm - 32) >> 3);
        const float* base = pm < 32 ? base_p + (size_t)pm * 256 * 1024 : base_s + (size_t)(pm - 32) * 256 * 1024;
        float* o = out + (size_t)pm * 256 * 1024;
        const int col0 = u.pn * 256 + wc * 32 + 4 * fq;
        f32x4 gv[2][2];
#pragma unroll
        for (int bj = 0; bj < 2; ++bj)
#pragma unroll
            for (int n = 0; n < 2; ++n) gv[bj][n] = *(const f32x4*)(gate + cond * 6144 + col0 + bj * 128 + n * 16);
#pragma unroll
        for (int ai = 0; ai < 2; ++ai) {
            f32x4 bs[4][2][2];
#pragma unroll
            for (int m = 0; m < 4; ++m) { const size_t ro = (size_t)(ai * 128 + wr * 64 + m * 16 + fr) * 1024 + col0;
#pragma unroll
                for (int bj = 0; bj < 2; ++bj)
#pragma unroll
                    for (int n = 0; n < 2; ++n) bs[m][bj][n] = *(const f32x4*)(base + ro + bj * 128 + n * 16); }
            asm volatile("" ::: "memory");
#pragma unroll
            for (int m = 0; m < 4; ++m) { const size_t ro = (size_t)(ai * 128 + wr * 64 + m * 16 + fr) * 1024 + col0;
#pragma unroll
                for (int bj = 0; bj < 2; ++bj)
#pragma unroll
                    for (int n = 0; n < 2; ++n) *(f32x4*)(o + ro + bj * 128 + n * 16) = bs[m][bj][n] + gv[bj][n] * acc[ai][bj][m][n]; }
            asm volatile("" ::: "memory");
        }
    }
};

struct EpiSwiglu {
    static constexpr bool PERM = false, AFTER_DRAIN = false;
    bf16_t* H;
    __device__ __forceinline__ void operator()(const f32x4 (&acc)[2][2][4][2], const Unit& u, int wr, int wc, int fr, int fq) const {
        asm volatile("" : "+v"(fr), "+v"(fq));
        bf16_t* dst = H + (size_t)(u.pm * 256) * 2816 + u.pn * 128 + wc * 32 + 4 * fq;
#pragma unroll
        for (int ai = 0; ai < 2; ++ai)
#pragma unroll
            for (int m = 0; m < 4; ++m) {
                const int rl = ai * 128 + wr * 64 + m * 16 + fr;
#pragma unroll
                for (int n = 0; n < 2; ++n) {
                    const f32x4 g = acc[ai][0][m][n], up = acc[ai][1][m][n]; f32x4 h;
#pragma unroll
                    for (int j = 0; j < 4; ++j) h[j] = g[j] * __builtin_amdgcn_rcpf(1.0f + __expf(-g[j])) * up[j];
                    *(u32x2*)(dst + (size_t)rl * 2816 + 16 * n) = pack4(h);
                }
            }
    }
};

template <class Epi, class Sched, bool ALIGN_EPI = false, bool SP2 = false>
__device__ __forceinline__ void gemm_phase(PG8_LAS unsigned char* lds, const Gemm g, const Sched& S, const Epi& E) {
    const int tid = threadIdx.x, wid = __builtin_amdgcn_readfirstlane(tid >> 6), lane = tid & 63, wr = wid >> 2, wc = wid & 3, fr = lane & 15, fq = lane >> 4;
    const int K = g.K, nt = K / BK;
    unsigned voffA[2], voffB[2];
#pragma unroll
    for (int i = 0; i < 2; ++i) { int R, C; stage_rc(tid * 16 + i * 8192, R, C); const int Rb = Epi::PERM ? ((R & ~31) + perm32(R & 31)) : R;
        voffA[i] = (unsigned)(R * K + C) * 2u; voffB[i] = (unsigned)(Rb * K + C) * 2u; }
    const size_t kstep = (size_t)(BK * 2);
    const size_t hstep = (size_t)HALF * K * 2;
    const size_t tstep = 2 * hstep;
    const unsigned ldsw = (unsigned)wid * 1024u;
    const int aoff = lds_byte(wr * 64 + fr, fq * 8), boff = lds_byte(wc * 32 + fr, fq * 8);
#define PG8_SA(b, h) (((b) * 2 + (h)) * HTB)
#define PG8_SB(b, h) ((4 + (b) * 2 + (h)) * HTB)
#define PG8_STAGE(bufoff, gbase, voff) do { _Pragma("unroll") for (int _i = 0; _i < 2; ++_i) \
        __builtin_amdgcn_global_load_lds((const unsigned*)((const char*)(gbase) + (voff)[_i]), (PG8_LAS unsigned*)(lds + (bufoff) + ldsw + _i * 8192), 16, 0, 0); } while (0)
#define PG8_LDA(dst, b, h) do { _Pragma("unroll") for (int m = 0; m < 4; ++m) _Pragma("unroll") for (int k = 0; k < 2; ++k) dst[m][k] = *(const PG8_LAS bf16x8*)(lds + PG8_SA(b, h) + aoff + m * 2048 + k * 1024); } while (0)
#define PG8_LDB(dst, b, h) do { _Pragma("unroll") for (int n = 0; n < 2; ++n) _Pragma("unroll") for (int k = 0; k < 2; ++k) dst[n][k] = *(const PG8_LAS bf16x8*)(lds + PG8_SB(b, h) + boff + n * 2048 + k * 1024); } while (0)
#define PG8_MMA(ai, bj, At, Bt) do { __builtin_amdgcn_s_setprio(1); _Pragma("unroll") for (int m = 0; m < 4; ++m) _Pragma("unroll") for (int n = 0; n < 2; ++n) _Pragma("unroll") for (int k = 0; k < 2; ++k) \
        acc[ai][bj][m][n] = __builtin_amdgcn_mfma_f32_16x16x32_bf16(Bt[n][k], At[m][k], acc[ai][bj][m][n], 0, 0, 0); __builtin_amdgcn_s_setprio(0); } while (0)
#define PG8_WAIT_V(n) asm volatile("s_waitcnt vmcnt(" #n ")" ::: "memory")
#define PG8_WAIT_L(n) asm volatile("s_waitcnt lgkmcnt(" #n ")" ::: "memory")
#define PG8_BAR __builtin_amdgcn_s_barrier()
#define PG8_SCHED __builtin_amdgcn_sched_barrier(0)
    Unit cur, nxt; int ui = 0;
    if (!S.next(0, cur)) return;
    f32x4 acc[2][2][4][2];
#pragma unroll
    for (int a = 0; a < 2; ++a)
#pragma unroll
        for (int b = 0; b < 2; ++b)
#pragma unroll
            for (int m = 0; m < 4; ++m)
#pragma unroll
                for (int n = 0; n < 2; ++n) acc[a][b][m][n] = (f32x4){0.f, 0.f, 0.f, 0.f};
    bf16x8 At[4][2], B0[2][2], B1[2][2];
    const char* cA = (const char*)g.A + (size_t)cur.pm * tstep; const char* cB = (const char*)g.Bt + (size_t)cur.pn * tstep;
    S.a_ready(cur);
    if constexpr (SP2) {
        PG8_STAGE(PG8_SB(0, 0), cB, voffB); PG8_STAGE(PG8_SB(0, 1), cB + hstep, voffB); PG8_STAGE(PG8_SA(0, 0), cA, voffA); PG8_STAGE(PG8_SA(0, 1), cA + hstep, voffA);
        if (wr == 1) PG8_BAR;
        PG8_WAIT_V(2); PG8_BAR;
        PG8_STAGE(PG8_SB(1, 0), cB + kstep, voffB); PG8_STAGE(PG8_SA(1, 0), cA + kstep, voffA); PG8_STAGE(PG8_SB(1, 1), cB + hstep + kstep, voffB);
        PG8_WAIT_V(6); PG8_BAR;
    } else {
        PG8_STAGE(PG8_SB(0, 0), cB, voffB); PG8_STAGE(PG8_SA(0, 0), cA, voffA); PG8_STAGE(PG8_SB(0, 1), cB + hstep, voffB); PG8_STAGE(PG8_SA(0, 1), cA + hstep, voffA);
        if (wr == 1) PG8_BAR;
        PG8_WAIT_V(4); PG8_BAR;
        PG8_STAGE(PG8_SB(1, 0), cB + kstep, voffB); PG8_STAGE(PG8_SA(1, 0), cA + kstep, voffA); PG8_STAGE(PG8_SB(1, 1), cB + hstep + kstep, voffB);
        PG8_WAIT_V(6); PG8_BAR;
    }
    for (;;) {
        const bool has_next = S.next(ui + 1, nxt);
        const char* nA = has_next ? (const char*)g.A + (size_t)nxt.pm * tstep : cA; const char* nB = has_next ? (const char*)g.Bt + (size_t)nxt.pn * tstep : cB;
        for (int t = 0; t < nt; t += 2) {
            const bool last = (t == nt - 2);
            const char* a1 = cA + (size_t)(t + 1) * kstep;
            const char* a2 = last ? nA : cA + (size_t)(t + 2) * kstep; const char* b2 = last ? nB : cB + (size_t)(t + 2) * kstep;
            const char* a3 = a2 + kstep; const char* b3 = b2 + kstep;
            if (last && has_next) S.a_ready(nxt);
            if constexpr (SP2) {
            PG8_LDB(B0, 0, 0); PG8_LDB(B1, 0, 1); PG8_SCHED; PG8_LDA(At, 0, 0); PG8_STAGE(PG8_SA(1, 1), a1 + hstep, voffA);
            PG8_WAIT_V(8); PG8_WAIT_L(0); PG8_BAR; PG8_MMA(0, 0, At, B0); PG8_MMA(0, 1, At, B1); PG8_BAR; PG8_SCHED;
            PG8_LDA(At, 0, 1); PG8_STAGE(PG8_SB(0, 0), b2, voffB); PG8_STAGE(PG8_SB(0, 1), b2 + hstep, voffB); PG8_STAGE(PG8_SA(0, 0), a2, voffA);
            PG8_WAIT_V(8); PG8_WAIT_L(0); PG8_BAR; PG8_MMA(1, 0, At, B0); PG8_MMA(1, 1, At, B1); PG8_BAR; PG8_SCHED;
            PG8_LDB(B0, 1, 0); PG8_LDB(B1, 1, 1); PG8_SCHED; PG8_LDA(At, 1, 0); PG8_STAGE(PG8_SA(0, 1), a2 + hstep, voffA);
            PG8_WAIT_V(8); PG8_WAIT_L(0); PG8_BAR; PG8_MMA(0, 0, At, B0); PG8_MMA(0, 1, At, B1); PG8_BAR; PG8_SCHED;
            PG8_LDA(At, 1, 1); PG8_STAGE(PG8_SB(1, 0), b3, voffB); PG8_STAGE(PG8_SB(1, 1), b3 + hstep, voffB); PG8_STAGE(PG8_SA(1, 0), a3, voffA);
            PG8_WAIT_V(8); PG8_WAIT_L(0); PG8_BAR; PG8_MMA(1, 0, At, B0); PG8_MMA(1, 1, At, B1); PG8_BAR; PG8_SCHED;
            } else {
            PG8_LDB(B0, 0, 0); PG8_SCHED; PG8_LDA(At, 0, 0); PG8_STAGE(PG8_SA(1, 1), a1 + hstep, voffA);
            PG8_WAIT_L(8); PG8_BAR; PG8_WAIT_L(0); PG8_MMA(0, 0, At, B0); PG8_BAR; PG8_SCHED;
            PG8_LDB(B1, 0, 1); PG8_STAGE(PG8_SB(0, 0), b2, voffB);
            PG8_BAR; PG8_WAIT_L(0); PG8_MMA(0, 1, At, B1); PG8_BAR;
            PG8_LDA(At, 0, 1); PG8_STAGE(PG8_SA(0, 0), a2, voffA);
            PG8_BAR; PG8_WAIT_L(0); PG8_MMA(1, 0, At, B0); PG8_BAR; PG8_SCHED;
            PG8_STAGE(PG8_SB(0, 1), b2 + hstep, voffB);
            PG8_WAIT_V(6); PG8_BAR; PG8_MMA(1, 1, At, B1); PG8_BAR;
            PG8_LDB(B0, 1, 0); PG8_SCHED; PG8_LDA(At, 1, 0); PG8_STAGE(PG8_SA(0, 1), a2 + hstep, voffA);
            PG8_WAIT_L(8); PG8_BAR; PG8_WAIT_L(0); PG8_MMA(0, 0, At, B0); PG8_BAR; PG8_SCHED;
            PG8_LDB(B1, 1, 1); PG8_STAGE(PG8_SB(1, 0), b3, voffB);
            PG8_BAR; PG8_WAIT_L(0); PG8_MMA(0, 1, At, B1); PG8_BAR;
            PG8_LDA(At, 1, 1); PG8_STAGE(PG8_SA(1, 0), a3, voffA);
            PG8_BAR; PG8_WAIT_L(0); PG8_MMA(1, 0, At, B0); PG8_BAR; PG8_SCHED;
            PG8_STAGE(PG8_SB(1, 1), b3 + hstep, voffB);
            PG8_WAIT_V(6); PG8_BAR; PG8_MMA(1, 1, At, B1); PG8_BAR;
            }
        }
        if constexpr (ALIGN_EPI) { if (wr == 0) PG8_BAR; }
        if constexpr (!Epi::AFTER_DRAIN) { E(acc, cur, wr, wc, fr, fq); S.done(cur); }
        if (!has_next) break;
#pragma unroll
        for (int a = 0; a < 2; ++a)
#pragma unroll
            for (int b = 0; b < 2; ++b)
#pragma unroll
                for (int m = 0; m < 4; ++m)
#pragma unroll
                    for (int n = 0; n < 2; ++n) acc[a][b][m][n] = (f32x4){0.f, 0.f, 0.f, 0.f};
        cur = nxt; cA = nA; cB = nB; ++ui;
        if constexpr (ALIGN_EPI) { if (wr == 1) PG8_BAR; }
    }
    PG8_WAIT_V(0);
    if constexpr (!ALIGN_EPI) { if (wr == 0) PG8_BAR; }
    PG8_BAR;
    if constexpr (Epi::AFTER_DRAIN) { E.fused(acc, cur, wr, wc, fr, fq, lds, wid, lane); S.done(cur); }
#undef PG8_SA
#undef PG8_SB
#undef PG8_STAGE
#undef PG8_LDA
#undef PG8_LDB
#undef PG8_MMA
#undef PG8_WAIT_V
#undef PG8_WAIT_L
#undef PG8_BAR
#undef PG8_SCHED
}
}

#define LAS __attribute__((address_space(3)))
typedef float f32x4 __attribute__((ext_vector_type(4)));
typedef float f32x16 __attribute__((ext_vector_type(16)));
typedef short bf16x8 __attribute__((ext_vector_type(8)));
typedef unsigned u32x4 __attribute__((ext_vector_type(4)));
typedef unsigned u32x2 __attribute__((ext_vector_type(2)));

constexpr int LDS_BYTES = 147456 + 256;
constexpr size_t WS_BAR = 900 * 1024;
constexpr int NPHASE = 8;

struct Params { const float* in[25]; float* out; unsigned char* ws; int ph_lo, ph_hi; };
typedef const __attribute__((address_space(4))) Params* KP;
__device__ __forceinline__ KP kargs() { unsigned long long k = (unsigned long long)__builtin_amdgcn_kernarg_segment_ptr(); asm volatile("" : "+s"(k)); return (KP)k; }

__device__ __forceinline__ float wave_sum(float v) {
#pragma unroll
    for (int o = 1; o < 64; o <<= 1) v += __shfl_xor(v, o);
    return v;
}
__device__ __forceinline__ unsigned pk2(float lo, float hi) { return pg8::cvt_pk_bf16(lo, hi); }

__device__ __forceinline__ void sincos_small(float x, float& s, float& c) {
    const float k = rintf(x * 0.636619772367581343f);
    float r = fmaf(-k, 1.57079601287841796875f, x);
    r = fmaf(-k, 3.1391647326017846e-7f, r);
    r = fmaf(-k, 5.3903025299577648e-15f, r);
    const float r2 = r * r;
    float sp = fmaf(r2, 2.7183114939898219064e-6f, -1.9839334836096632576e-4f); sp = fmaf(sp, r2, 8.3333293858894631756e-3f); sp = fmaf(sp, r2, -1.6666665896820998054e-1f);
    const float sn = fmaf(r * r2, sp, r);
    float cp = fmaf(r2, 2.4433157118340246e-5f, -1.3887316255899256e-3f); cp = fmaf(cp, r2, 4.1666645655422476e-2f); cp = fmaf(cp, r2, -0.5f);
    const float cs = fmaf(cp, r2, 1.0f);
    const int q = ((int)k) & 3;
    const float s0 = (q & 1) ? cs : sn, c0 = (q & 1) ? sn : cs;
    s = (q & 2) ? -s0 : s0;
    c = ((q + 1) & 2) ? -c0 : c0;
}

template <int MAP>
__device__ __forceinline__ int dest_row(int n0) {
    if (MAP == 1) { const int pn = n0 >> 8, x = n0 & 255, wc = x >> 6, bj = (x >> 5) & 1; return (pn << 8) + (bj << 7) + (wc << 5); }
    if (MAP == 2) { const int bj = n0 >= DFF ? 1 : 0, rem = n0 - bj * DFF, pn = rem >> 7, x = rem & 127; return (pn << 8) + (bj << 7) + x; }
    return n0;
}
template <int MAP>
__device__ __forceinline__ void p0_transpose_item(const float* W, int K, int N, bf16* WT, LAS float* scr, int item, int lane) {
    const int nblk = N / 32, kb = item / nblk, nb = item % nblk, k0 = 64 * kb, n0 = 32 * nb;
    float wv[32];
#pragma unroll
    for (int i = 0; i < 32; ++i) wv[i] = W[(size_t)(k0 + 2 * i + (lane >> 5)) * N + n0 + (lane & 31)];
#pragma unroll
    for (int i = 0; i < 32; ++i) scr[(2 * i + (lane >> 5)) * 33 + (lane & 31)] = wv[i];
    asm volatile("s_waitcnt lgkmcnt(0)" ::: "memory");
    const int c = lane & 7; const int dr = dest_row<MAP>(n0);
#pragma unroll
    for (int j = 0; j < 4; ++j) { const int n = (lane >> 3) + 8 * j; const LAS float* s = scr + (8 * c) * 33 + n;
        u32x4 o; o.x = pk2(s[0 * 33], s[1 * 33]); o.y = pk2(s[2 * 33], s[3 * 33]); o.z = pk2(s[4 * 33], s[5 * 33]); o.w = pk2(s[6 * 33], s[7 * 33]);
        *(u32x4*)(WT + (size_t)(dr + n) * K + k0 + 8 * c) = o; }
    asm volatile("s_waitcnt lgkmcnt(0)" ::: "memory");
}

__device__ __forceinline__ void p0_ada(KP P, LAS unsigned char* lds, int tid, int lane, int wave) {
    unsigned char* ws = P->ws;
    const int G = gridDim.x, bx = blockIdx.x;
    const int gt = bx * 512 + tid, NGT = G * 512;
    for (int i = gt; i < NTOK; i += NGT) ((f32x4*)(ws + WS_SSQ))[i] = (f32x4){0.f, 0.f, 0.f, 0.f};
    if (bx == G - 1) {
        for (int i = tid; i < 1024; i += 512) {
            const int pos = i >> 4, f = i & 15;
            const float inv = exp2f(-(float)(2 * f) * (1.0f / 32.0f) * 13.287712379549449f);
            float s, c; sincos_small((float)pos * inv, s, c);
            ((float*)(ws + WS_ROPEC))[i] = c; ((float*)(ws + WS_ROPES))[i] = s;
        }
    }
    LAS float* scond = (LAS float*)lds;
    LAS float* red = (LAS float*)(lds + 36864);
    const float* wada = P->in[8]; const float* bada = P->in[9]; float* mods = (float*)(ws + WS_MODS);
    bool have = false;
    for (int it = bx; it < 192; it += G) {
        const int n0 = it * 32, c4 = (lane & 7) * 4, rg = lane >> 3, kbase = wave * 128 + rg;
        f32x4 w[16];
#pragma unroll
        for (int i = 0; i < 16; ++i) w[i] = *(const f32x4*)(wada + (size_t)(kbase + 8 * i) * 6144 + n0 + c4);
        if (!have) {
            for (int idx = tid; idx < 9216; idx += 512) { const int c = idx >> 10, k = idx & 1023; const float x = c == 0 ? P->in[5][k] : P->in[4][(c - 1) * 1024 + k]; scond[idx] = x / (1.0f + __expf(-x)); }
            have = true;
        }
        __syncthreads();
        f32x4 a[9];
#pragma unroll
        for (int c = 0; c < 9; ++c) a[c] = (f32x4){0.f, 0.f, 0.f, 0.f};
#pragma unroll
        for (int i = 0; i < 16; ++i) {
#pragma unroll
            for (int c = 0; c < 9; ++c) a[c] += w[i] * scond[c * 1024 + kbase + 8 * i]; }
#pragma unroll
        for (int c = 0; c < 9; ++c)
#pragma unroll
            for (int j = 0; j < 4; ++j) { float v = a[c][j]; v += __shfl_xor(v, 8); v += __shfl_xor(v, 16); v += __shfl_xor(v, 32); a[c][j] = v; }
        if (lane < 8) {
#pragma unroll
            for (int c = 0; c < 9; ++c) *(LAS f32x4*)(red + (wave * 9 + c) * 32 + c4) = a[c]; }
        __syncthreads();
        if (tid < 288) { const int c = tid >> 5, cl = tid & 31; float s = 0.f;
#pragma unroll
            for (int p = 0; p < 8; ++p) s += red[(p * 9 + c) * 32 + cl];
            mods[c * 6144 + n0 + cl] = s + bada[n0 + cl]; }
    }
    __syncthreads();
}

__device__ __forceinline__ void convert_job(KP P, LAS unsigned char* lds, int tid, int lane, int wave, int what, int rank, int nblk) {
    unsigned char* ws = P->ws;
    const int gt = rank * 512 + tid, NGT = nblk * 512;
    if (what & 1) {
        const float* ck = P->in[2]; bf16* Ks = (bf16*)(ws + WS_KS);
        for (int i = gt; i < 262144; i += NGT) {
            const int c = i & 7, s = (i >> 3) & 511, bhm = i >> 12;
            const f32x4 a = *(const f32x4*)(ck + (size_t)i * 8), b2 = *(const f32x4*)(ck + (size_t)i * 8 + 4);
            u32x4 o; o.x = pk2(a[0], a[1]); o.y = pk2(a[2], a[3]); o.z = pk2(b2[0], b2[1]); o.w = pk2(b2[2], b2[3]);
            *(u32x4*)(Ks + ((size_t)bhm * 2560 + 2048 + s) * 64 + c * 8) = o;
        }
        const float* cv = P->in[3]; bf16* VTs = (bf16*)(ws + WS_VTS);
        for (int i = gt; i < 262144; i += NGT) {
            const int sc = ((i >> 10) & 7) * 8 + (i & 7), dv = (i >> 3) & 127, bh = i >> 13;
            const float* src = cv + ((size_t)bh * 512 + sc * 8) * 128 + dv;
            float v8[8];
#pragma unroll
            for (int j = 0; j < 8; ++j) v8[j] = src[128 * j];
            asm volatile("" ::: "memory");
            u32x4 o; o.x = pk2(v8[0], v8[1]); o.y = pk2(v8[2], v8[3]); o.z = pk2(v8[4], v8[5]); o.w = pk2(v8[6], v8[7]);
            *(u32x4*)(VTs + ((size_t)bh * 128 + dv) * 2560 + 2048 + sc * 8) = o;
        }
    }
    {
        LAS float* scr = (LAS float*)(lds + wave * 16384);
        const int gw = rank * 8 + wave, NGW = nblk * 8;
        const int I1 = (what & 2) ? 16 * 80 : 0, I2 = (what & 4) ? 16 * 32 : 0, I3 = (what & 8) ? 16 * 176 : 0, I4 = (what & 16) ? 44 * 32 : 0, NITEMS = I1 + I2 + I3 + I4;
        for (int it = gw; it < NITEMS; it += NGW) {
            int r = it;
            if (r < I1) { p0_transpose_item<1>(P->in[10], 1024, NIN, (bf16*)(ws + WS_W1T), scr, r, lane); continue; } r -= I1;
            if (r < I2) { p0_transpose_item<0>(P->in[22], 1024, 1024, (bf16*)(ws + WS_W2T), scr, r, lane); continue; } r -= I2;
            if (r < I3) { p0_transpose_item<2>(P->in[23], 1024, 2 * DFF, (bf16*)(ws + WS_W3T), scr, r, lane); continue; } r -= I3;
            p0_transpose_item<0>(P->in[24], DFF, 1024, (bf16*)(ws + WS_W4T), scr, r, lane);
        }
    }
}

__device__ __forceinline__ void norm_phase(const float* xp, const float* xs, const float* g, const float* mods, int shift_off, int scale_off, bf16* XM, int lane, int wave) {
    const int gw = blockIdx.x * 8 + wave, NGW = gridDim.x * 8;
    constexpr int R = 3;
    for (int m0 = gw * R; m0 < NTOK; m0 += NGW * R) {
        f32x4 v[R][4];
#pragma unroll
        for (int rr = 0; rr < R; ++rr) { const int m = m0 + rr;
            const float* xrow = m < NPROMPT ? xp + (size_t)m * DM : xs + (size_t)(m - NPROMPT) * DM;
            const f32x4* xr = (const f32x4*)xrow + lane;
#pragma unroll
            for (int j = 0; j < 4; ++j) v[rr][j] = xr[64 * j]; }
#pragma unroll
        for (int rr = 0; rr < R; ++rr) { const int m = m0 + rr;
            const int cond = m < NPROMPT ? 0 : 1 + ((m - NPROMPT) >> 11);
            float s = 0.f;
#pragma unroll
            for (int j = 0; j < 4; ++j) { const f32x4 q = v[rr][j] * v[rr][j]; s += (q[0] + q[1]) + (q[2] + q[3]); }
            const float rstd = rsqrtf(wave_sum(s) * (1.0f / DM) + 1e-6f);
            const float* sh = mods + cond * 6144 + shift_off; const float* sc = mods + cond * 6144 + scale_off;
            u32x2* o8 = (u32x2*)(XM + (size_t)m * DM) + lane;
#pragma unroll
            for (int j = 0; j < 4; ++j) {
                const f32x4 gg = ((const f32x4*)g)[lane + 64 * j], s1 = ((const f32x4*)sc)[lane + 64 * j], h1 = ((const f32x4*)sh)[lane + 64 * j];
                const f32x4 y = v[rr][j] * rstd * gg * (1.0f + s1) + h1;
                u32x2 w; w.x = pk2(y[0], y[1]); w.y = pk2(y[2], y[3]); o8[64 * j] = w;
            }
        }
    }
}

__device__ __forceinline__ void sgu_phase(KP P, LAS unsigned char* lds, int tid, int lane, int wave) {
    unsigned char* ws = P->ws;
    const float* ssq = (const float*)(ws + WS_SSQ);
    const bf16* U = (const bf16*)(ws + WS_U);
    bf16* MIX = (bf16*)(ws + WS_XM);
    const float* sng = P->in[18]; const float* sw = P->in[19]; const float* sb = P->in[20]; const float* mog = P->in[21];
    const int r = lane & 31, h = lane >> 5, pb = wave & 3, ch2 = wave >> 2;
    constexpr int TP = 272;
    LAS unsigned char* A = lds;
    LAS unsigned char* B = lds + 32768;
    LAS unsigned char* UT = lds + 65536;
    LAS unsigned char* OT = lds + 65536 + 128 * TP;
    LAS float* red = (LAS float*)(lds + 65536 + 256 * TP);
    LAS float* rsq = red + 256;
    LAS float* rstv = rsq + 512;
    for (int ck = blockIdx.x; ck < 192; ck += gridDim.x) {
        const bool prompt = ck < 64;
        const int b = prompt ? (ck >> 1) : ((ck - 64) >> 4), s0 = prompt ? ((ck & 1) << 7) : (((ck - 64) & 15) << 7), Sx = prompt ? 256 : 2048;
        const bf16* GVT = prompt ? (const bf16*)(ws + WS_GVTP) : (const bf16*)(ws + WS_GVTS);
        const int tok0 = ck * 128;
        __syncthreads();
        { const int q = tid >> 2, g = tid & 3; rsq[g * 128 + q] = rsqrtf(ssq[(size_t)(tok0 + q) * 4 + g] * (1.0f / 128.0f) + 1e-6f); }
        const int p = pb * 32 + r;
        float ss = 0.f;
#pragma unroll 1
        for (int g = 0; g < 4; ++g) {
            __syncthreads();
#pragma unroll
            for (int i = 0; i < 4; ++i) { const int q = tid + 512 * i, c = q >> 4, cc = q & 15;
                const u32x4 v = *(const u32x4*)(GVT + ((size_t)b * 512 + g * 128 + c) * Sx + s0 + cc * 8);
                const u32x4 uu = *(const u32x4*)(U + (size_t)(tok0 + c) * 512 + g * 128 + cc * 8);
                *(LAS u32x4*)(A + c * 256 + ((cc ^ (c & 15)) << 4)) = v;
                *(LAS u32x4*)(UT + c * TP + cc * 16) = uu; }
            asm volatile("" ::: "memory");
#pragma unroll
            for (int i = 0; i < 8; ++i) { const int idx = tid + 512 * i, pp = idx >> 5, q4 = (idx & 31) << 2;
                const f32x4 w = *(const f32x4*)(sw + (size_t)g * 16384 + pp * 128 + q4);
                const f32x4 rs = *(const LAS f32x4*)(rsq + g * 128 + q4);
                const f32x4 y = w * rs; u32x2 o; o.x = pk2(y[0], y[1]); o.y = pk2(y[2], y[3]);
                const int cc = q4 >> 3;
                *(LAS u32x2*)(B + pp * 256 + ((cc ^ (pp & 15)) << 4) + ((q4 & 4) << 1)) = o;
                if (i == 3) asm volatile("" ::: "memory"); }
            __syncthreads();
            f32x16 acc[2]; acc[0] = (f32x16)(0.f); acc[1] = (f32x16)(0.f);
#pragma unroll
            for (int ks = 0; ks < 8; ++ks) {
                const bf16x8 bw = *(const LAS bf16x8*)(B + p * 256 + (((2 * ks + h) ^ (p & 15)) << 4));
#pragma unroll
                for (int t = 0; t < 2; ++t) { const int crow = (ch2 * 2 + t) * 32 + r;
                    const bf16x8 ag = *(const LAS bf16x8*)(A + crow * 256 + (((2 * ks + h) ^ (crow & 15)) << 4));
                    acc[t] = __builtin_amdgcn_mfma_f32_32x32x16_bf16(ag, bw, acc[t], 0, 0, 0); }
            }
            const float bp = sb[g * 128 + p];
#pragma unroll
            for (int t = 0; t < 2; ++t)
#pragma unroll
                for (int q = 0; q < 4; ++q) {
                    const int c = (ch2 * 2 + t) * 32 + 8 * q + 4 * h;
                    const f32x4 gn = *(const f32x4*)(sng + g * 128 + c);
                    const u32x2 uu = *(const LAS u32x2*)(UT + p * TP + c * 2);
                    float uf[4]; uf[0] = __uint_as_float(uu.x << 16); uf[1] = __uint_as_float(uu.x & 0xffff0000u); uf[2] = __uint_as_float(uu.y << 16); uf[3] = __uint_as_float(uu.y & 0xffff0000u);
                    float v[4];
#pragma unroll
                    for (int j = 0; j < 4; ++j) { v[j] = uf[j] * fmaf(gn[j], acc[t][4 * q + j], bp); ss = fmaf(v[j], v[j], ss); }
                    u32x2 o; o.x = pk2(v[0], v[1]); o.y = pk2(v[2], v[3]);
                    *(LAS u32x2*)(OT + p * TP + c * 2) = o;
                }
            __syncthreads();
#pragma unroll
            for (int i = 0; i < 4; ++i) { const int q = tid + 512 * i, row = q >> 4, cc = q & 15;
                *(u32x4*)(MIX + (size_t)(tok0 + row) * 1024 + 512 + g * 128 + cc * 8) = *(const LAS u32x4*)(OT + row * TP + cc * 16); }
        }
        ss += __shfl_xor(ss, 32);
        if (h == 0) red[ch2 * 128 + p] = ss;
        __syncthreads();
        if (tid < 128) rstv[tid] = rsqrtf((red[tid] + red[128 + tid]) * (1.0f / 512.0f) + 1e-6f);
        __syncthreads();
#pragma unroll 4
        for (int i = 0; i < 16; ++i) { const int q = tid + 512 * i, row = q >> 6, cc = q & 63;
            u32x4* mp = (u32x4*)(MIX + (size_t)(tok0 + row) * 1024 + 512 + cc * 8);
            const u32x4 x = *mp; const float rs = rstv[row];
            const f32x4 m0 = *(const f32x4*)(mog + cc * 8), m1 = *(const f32x4*)(mog + cc * 8 + 4);
            u32x4 o;
            o.x = pk2(__uint_as_float(x.x << 16) * rs * m0[0], __uint_as_float(x.x & 0xffff0000u) * rs * m0[1]);
            o.y = pk2(__uint_as_float(x.y << 16) * rs * m0[2], __uint_as_float(x.y & 0xffff0000u) * rs * m0[3]);
            o.z = pk2(__uint_as_float(x.z << 16) * rs * m1[0], __uint_as_float(x.z & 0xffff0000u) * rs * m1[1]);
            o.w = pk2(__uint_as_float(x.w << 16) * rs * m1[2], __uint_as_float(x.w & 0xffff0000u) * rs * m1[3]);
            *mp = o; }
    }
    __syncthreads();
}

__device__ __forceinline__ float max3f(float a, float b, float c) { float r; asm("v_max3_f32 %0, %1, %2, %3" : "=v"(r) : "v"(a), "v"(b), "v"(c)); return r; }
__device__ __forceinline__ void attn_unit(LAS unsigned char* lds, const bf16* Qb, int Sq, int q0, const bf16* Kb, const bf16* VTb, int Sk,
                                          bf16* mixp, const float* gout, float lam, int tid, int lane, int wave, int tmul = 1) {
    const int r = lane & 31, h = lane >> 5, qsub = wave >> 1, map = wave & 1;
    const int nt = Sk >> 6;
    bf16x8 qf[4];
    { const bf16* qp = Qb + ((size_t)map * Sq + q0 + qsub * 32 + r) * 64 + 8 * h;
#pragma unroll
      for (int ks = 0; ks < 4; ++ks) qf[ks] = *(const bf16x8*)(qp + 16 * ks); }
    const bf16* K1 = Kb; const bf16* K2 = Kb + (size_t)Sk * 64;
    const int srow = tid >> 3, sc = tid & 7;
    const int so = srow * 128 + ((sc ^ ((srow >> 1) & 7)) << 4);
    const bf16* gk1 = K1 + tid * 8; const bf16* gk2 = K2 + tid * 8;
    const bf16* gv0 = VTb + (size_t)srow * Sk + sc * 8; const bf16* gv1 = gv0 + (size_t)64 * Sk;
    const int kr = (r & 19) | ((r & 4) << 1) | ((r & 8) >> 1);
    const int kx = (h ^ ((kr >> 1) & 7)) << 4, koff = map * 8192 + kr * 128;
    const int vx = (h ^ ((r >> 1) & 7)) << 4, voff = 16384 + r * 128;
    f32x16 O[4];
#pragma unroll
    for (int i = 0; i < 4; ++i) O[i] = (f32x16)(0.f);
    float mrun = -1e30f, lsum = 0.f;
    const float C = 0.18033688011112042f;
    const float TLAZY = 8.0f / 0.18033688011112042f;
    u32x4 st0, st1, st2, st3;
    st0 = *(const u32x4*)gk1; st1 = *(const u32x4*)gk2; st2 = *(const u32x4*)gv0; st3 = *(const u32x4*)gv1;
    *(LAS u32x4*)(lds + so) = st0; *(LAS u32x4*)(lds + 8192 + so) = st1; *(LAS u32x4*)(lds + 16384 + so) = st2; *(LAS u32x4*)(lds + 24576 + so) = st3;
    __syncthreads();
    for (int t = 0; t < nt; ++t) {
        LAS unsigned char* buf = lds + ((t & 1) << 15);
        const bool p1 = t + 1 < nt;
        if (p1) { const int e = (t + 1) * tmul * 64;
            st0 = *(const u32x4*)(gk1 + (size_t)e * 64); st1 = *(const u32x4*)(gk2 + (size_t)e * 64); st2 = *(const u32x4*)(gv0 + e); st3 = *(const u32x4*)(gv1 + e); }
        bf16x8 fa[8], fb[8];
#pragma unroll
        for (int ks = 0; ks < 4; ++ks) { const int co = ((2 * ks) << 4) ^ kx; fa[2 * ks] = *(const LAS bf16x8*)(buf + koff + co); fa[2 * ks + 1] = *(const LAS bf16x8*)(buf + koff + 4096 + co); }
        __builtin_amdgcn_sched_barrier(0);
        f32x16 S0 = (f32x16)(0.f), S1 = (f32x16)(0.f);
#pragma unroll
        for (int ks = 0; ks < 4; ++ks) { S0 = __builtin_amdgcn_mfma_f32_32x32x16_bf16(fa[2 * ks], qf[ks], S0, 0, 0, 0); S1 = __builtin_amdgcn_mfma_f32_32x32x16_bf16(fa[2 * ks + 1], qf[ks], S1, 0, 0, 0); }
#pragma unroll
        for (int kk = 0; kk < 2; ++kk) { const int co = ((2 * kk) << 4) ^ vx;
#pragma unroll
            for (int d = 0; d < 4; ++d) fb[kk * 4 + d] = *(const LAS bf16x8*)(buf + voff + d * 4096 + co); }
        __builtin_amdgcn_sched_barrier(0);
        float mx; { float m0 = max3f(S0[0], S0[1], S0[2]), m1 = max3f(S0[3], S0[4], S0[5]), m2 = max3f(S0[6], S0[7], S0[8]), m3 = max3f(S0[9], S0[10], S0[11]);
            float m4 = max3f(S0[12], S0[13], S0[14]), m5 = max3f(S0[15], S1[0], S1[1]), m6 = max3f(S1[2], S1[3], S1[4]), m7 = max3f(S1[5], S1[6], S1[7]);
            float m8 = max3f(S1[8], S1[9], S1[10]), m9 = max3f(S1[11], S1[12], S1[13]), m10 = max3f(S1[14], S1[15], m0);
            m1 = max3f(m1, m2, m3); m4 = max3f(m4, m5, m6); m7 = max3f(m7, m8, m9); mx = max3f(m1, m4, m7); mx = max3f(mx, m10, m10); }
        { const u32x2 sw2 = __builtin_amdgcn_permlane32_swap(__float_as_uint(mx), __float_as_uint(mx), false, false); mx = max3f(__uint_as_float(sw2.x), __uint_as_float(sw2.y), mx); }
        if (__builtin_amdgcn_ballot_w64(mx > mrun + TLAZY) != 0ull) {
            const float mnew = (mx > mrun + TLAZY) ? mx : mrun; const float alpha = __builtin_amdgcn_exp2f((mrun - mnew) * C);
            mrun = mnew; lsum *= alpha;
#pragma unroll
            for (int d = 0; d < 4; ++d) O[d] = O[d] * alpha; }
        { const float mc = mrun * C; S0 = S0 * C - mc; S1 = S1 * C - mc; }
#pragma unroll
        for (int i = 0; i < 16; ++i) { S0[i] = __builtin_amdgcn_exp2f(S0[i]); S1[i] = __builtin_amdgcn_exp2f(S1[i]); }
        { const f32x16 sv = S0 + S1;
          lsum += ((sv[0] + sv[1]) + (sv[2] + sv[3])) + ((sv[4] + sv[5]) + (sv[6] + sv[7])) + (((sv[8] + sv[9]) + (sv[10] + sv[11])) + ((sv[12] + sv[13]) + (sv[14] + sv[15]))); }
        bf16x8 pf[4];
#pragma unroll
        for (int s2 = 0; s2 < 2; ++s2) { u32x4 w0, w1;
            w0.x = pk2(S0[8 * s2 + 0], S0[8 * s2 + 1]); w0.y = pk2(S0[8 * s2 + 2], S0[8 * s2 + 3]); w0.z = pk2(S0[8 * s2 + 4], S0[8 * s2 + 5]); w0.w = pk2(S0[8 * s2 + 6], S0[8 * s2 + 7]);
            w1.x = pk2(S1[8 * s2 + 0], S1[8 * s2 + 1]); w1.y = pk2(S1[8 * s2 + 2], S1[8 * s2 + 3]); w1.z = pk2(S1[8 * s2 + 4], S1[8 * s2 + 5]); w1.w = pk2(S1[8 * s2 + 6], S1[8 * s2 + 7]);
            pf[s2] = __builtin_bit_cast(bf16x8, w0); pf[2 + s2] = __builtin_bit_cast(bf16x8, w1); }
        __builtin_amdgcn_sched_barrier(0);
#pragma unroll
        for (int kk = 2; kk < 4; ++kk) { const int co = ((2 * kk) << 4) ^ vx;
#pragma unroll
            for (int d = 0; d < 4; ++d) fa[(kk - 2) * 4 + d] = *(const LAS bf16x8*)(buf + voff + d * 4096 + co); }
        __builtin_amdgcn_sched_barrier(0);
#pragma unroll
        for (int kk = 0; kk < 2; ++kk)
#pragma unroll
            for (int d = 0; d < 4; ++d) O[d] = __builtin_amdgcn_mfma_f32_32x32x16_bf16(fb[kk * 4 + d], pf[kk], O[d], 0, 0, 0);
#pragma unroll
        for (int kk = 2; kk < 4; ++kk)
#pragma unroll
            for (int d = 0; d < 4; ++d) O[d] = __builtin_amdgcn_mfma_f32_32x32x16_bf16(fa[(kk - 2) * 4 + d], pf[kk], O[d], 0, 0, 0);
        if (p1) { LAS unsigned char* nb = lds + (((t + 1) & 1) << 15);
            *(LAS u32x4*)(nb + so) = st0; *(LAS u32x4*)(nb + 8192 + so) = st1; *(LAS u32x4*)(nb + 16384 + so) = st2; *(LAS u32x4*)(nb + 24576 + so) = st3; }
        __syncthreads();
    }
    const float l = lsum + __shfl_xor(lsum, 32);
    LAS float* comb = (LAS float*)(lds + 65536 + qsub * 16384);
    if (map == 1) {
        const float f = lam / l;
#pragma unroll
        for (int d = 0; d < 4; ++d)
#pragma unroll
            for (int i = 0; i < 16; ++i) comb[(d * 16 + i) * 64 + lane] = O[d][i] * f;
    }
    __syncthreads();
    if (map == 0) {
        const float inv = 1.0f / l; float ss = 0.f;
#pragma unroll
        for (int d = 0; d < 4; ++d)
#pragma unroll
            for (int i = 0; i < 16; ++i) { const float o = fmaf(O[d][i], inv, -comb[(d * 16 + i) * 64 + lane]); O[d][i] = o; ss = fmaf(o, o, ss); }
        ss += __shfl_xor(ss, 32);
        const float rs = rsqrtf(ss * (1.0f / 128.0f) + 1e-6f) * 0.8f;
        int r2 = r; asm volatile("" : "+v"(r2));
        LAS unsigned char* ot = lds + (qsub * 32 + r2) * 272;
#pragma unroll
        for (int d = 0; d < 4; ++d)
#pragma unroll
            for (int q = 0; q < 4; ++q) {
                const int dv = 32 * d + 8 * q + 4 * h;
                const f32x4 gg = *(const f32x4*)(gout + dv);
                u32x2 o; o.x = pk2(O[d][4 * q] * rs * gg[0], O[d][4 * q + 1] * rs * gg[1]); o.y = pk2(O[d][4 * q + 2] * rs * gg[2], O[d][4 * q + 3] * rs * gg[3]);
                *(LAS u32x2*)(ot + dv * 2) = o;
                if (q & 1) asm volatile("" ::: "memory");
            }
    }
    __syncthreads();
    int t2 = tid; asm volatile("" : "+v"(t2));
#pragma unroll
    for (int i = 0; i < 4; ++i) { const int q = t2 + 512 * i, row = q >> 4, cc = q & 15;
        *(u32x4*)(mixp + (size_t)row * 1024 + cc * 8) = *(const LAS u32x4*)(lds + row * 272 + cc * 16); }
    __syncthreads();
}

__device__ __forceinline__ void attn_phase(KP P, LAS unsigned char* lds, int tid, int lane, int wave, bool shadow = false, int tmul = 1) {
    unsigned char* ws = P->ws;
    const float d1 = wave_sum(P->in[13][lane] * P->in[14][lane]), d2 = wave_sum(P->in[15][lane] * P->in[16][lane]);
    const float lam = __expf(d1) - __expf(d2) + 0.2f;
    bf16* MIX = shadow ? (bf16*)(ws + 206 * MiB) : (bf16*)(ws + WS_XM);
    const float* aog = P->in[17];
    const int G = gridDim.x, bx = blockIdx.x;
    const int n_items = (G == 256) ? (bx >= 192 ? 6 : 2) : 0;
    for (int it = 0, j = bx; (G == 256) ? (it < n_items) : (j < 768); ++it, j += G) {
        int jj = j;
        if (G == 256) jj = it < 2 ? bx + 256 * it : 512 + (bx - 192) * 4 + (it - 2);
        if (jj < 512) {
            const int x = jj & 7, idx = jj >> 3, grp = x * 4 + (idx >> 4), qb = idx & 15, b = grp >> 2, hh = grp & 3;
            attn_unit(lds, (const bf16*)(ws + WS_QS) + (size_t)(b * 4 + hh) * 2 * 2048 * 64, 2048, qb * 128,
                      (const bf16*)(ws + WS_KS) + (size_t)(b * 4 + hh) * 2 * 2560 * 64, (const bf16*)(ws + WS_VTS) + ((size_t)b * 512 + hh * 128) * 2560, 2560,
                      MIX + ((size_t)NPROMPT + b * 2048 + qb * 128) * 1024 + hh * 128, aog + hh * 128, lam, tid, lane, wave, tmul);
        } else {
            const int k = jj - 512, grp = k >> 1, qb = k & 1, b = grp >> 2, hh = grp & 3;
            attn_unit(lds, (const bf16*)(ws + WS_QP) + (size_t)(b * 4 + hh) * 2 * 256 * 64, 256, qb * 128,
                      (const bf16*)(ws + WS_KP) + (size_t)(b * 4 + hh) * 2 * 256 * 64, (const bf16*)(ws + WS_VTP) + ((size_t)b * 512 + hh * 128) * 256, 256,
                      MIX + ((size_t)b * 256 + qb * 128) * 1024 + hh * 128, aog + hh * 128, lam, tid, lane, wave, tmul);
        }
    }
}

#define RLX_AGENT __ATOMIC_RELAXED, __HIP_MEMORY_SCOPE_AGENT
#define XB_TMO      128
#define XB_XCNT(j)  (256  + 64 * (j))
#define XB_XSUB(j)  (1280 + 64 * (j))
#define XB_XGEN(j)  (2304 + 64 * (j))
#define XB_TOP      3328
#define XB_TOPGEN   3392
#define XCD_BAR_WORDS 3456
#define XB_SPIN_CAP (1u << 18)

__device__ __forceinline__ unsigned xb_ld(unsigned* p)              { return __hip_atomic_load(p, __ATOMIC_RELAXED, __HIP_MEMORY_SCOPE_AGENT); }
__device__ __forceinline__ unsigned xb_add(unsigned* p, unsigned v) { return __hip_atomic_fetch_add(p, v, __ATOMIC_RELAXED, __HIP_MEMORY_SCOPE_AGENT); }
__device__ __forceinline__ unsigned xb_xcc_id() { return (unsigned)__builtin_amdgcn_s_getreg((3 << 11) | 20) & 0xFu; }
#define XB_SPIN(cond, bar) do { unsigned _sp = 0; while (cond) { __builtin_amdgcn_s_sleep(1); \
    if ((++_sp & 255u) == 0u) { if (xb_ld(&(bar)[XB_TMO])) break; if (_sp > XB_SPIN_CAP) { atomicAdd(&(bar)[XB_TMO], 1u); break; } } } } while (0)

struct XcdBarrier {
    unsigned* bar; unsigned x;
    volatile LAS unsigned* st;
};

__device__ __forceinline__ XcdBarrier xcd_barrier_post(unsigned* bar, volatile LAS unsigned* st) {
    XcdBarrier b; b.bar = bar; b.x = xb_xcc_id(); b.st = st;
    if (threadIdx.x == 0) (void)xb_add(&bar[XB_XCNT(b.x)], 1u);
    return b;
}
__device__ __forceinline__ void xcd_barrier_complete(unsigned* bar, unsigned x, unsigned& nloc, unsigned& nx) {
    const unsigned G = gridDim.x * gridDim.y * gridDim.z;
    unsigned sum, cnt, mine, sp = 0u;
    for (;;) {
        sum = 0u; cnt = 0u; mine = 0u;
#pragma unroll
        for (unsigned j = 0; j < 16; ++j) { const unsigned c = xb_ld(&bar[XB_XCNT(j)]); sum += c; cnt += (c > 0u) ? 1u : 0u; mine = (j == x) ? c : mine; }
        if (sum == G) break;
        __builtin_amdgcn_s_sleep(1);
        if ((++sp & 255u) == 0u) { if (xb_ld(&bar[XB_TMO])) break; if (sp > XB_SPIN_CAP) { atomicAdd(&bar[XB_TMO], 1u); break; } }
    }
    nloc = mine > 0u ? mine : 1u; nx = cnt > 0u ? cnt : 1u;
}

__device__ __forceinline__ void xcd_barrier(const XcdBarrier& b) {
    asm volatile("s_waitcnt vmcnt(0)" ::: "memory");
    __syncthreads();
    if (threadIdx.x == 0) {
        unsigned* bar = b.bar;
        __builtin_amdgcn_s_waitcnt(0);
        unsigned nloc = b.st[0], nx = b.st[1];
        if (nloc == 0u) { xcd_barrier_complete(bar, b.x, nloc, nx); b.st[0] = nloc; b.st[1] = nx; }
        const unsigned old = xb_add(&bar[XB_XSUB(b.x)], 1u);
        const unsigned gen = old / nloc;
        if (old + 1u == (gen + 1u) * nloc) {
            __builtin_amdgcn_fence(__ATOMIC_RELEASE, "agent");
            asm volatile("s_waitcnt vmcnt(0)" ::: "memory");
            const unsigned og = xb_add(&bar[XB_TOP], 1u);
            const unsigned tg = og / nx;
            if (og + 1u == (tg + 1u) * nx) xb_add(&bar[XB_TOPGEN], 1u);
            else XB_SPIN(xb_ld(&bar[XB_TOPGEN]) == tg, bar);
            __builtin_amdgcn_fence(__ATOMIC_ACQUIRE, "agent");
            xb_add(&bar[XB_XGEN(b.x)], 1u);
            asm volatile("s_waitcnt vmcnt(0)" ::: "memory");
        } else {
            XB_SPIN(xb_ld(&bar[XB_XGEN(b.x)]) == gen, bar);
            __builtin_amdgcn_fence(__ATOMIC_ACQUIRE, "agent");
            asm volatile("s_waitcnt vmcnt(0)" ::: "memory");
        }
    }
    __syncthreads();
}

__global__ void __launch_bounds__(512, 2) fwd_megakernel(Params Parg) {
    extern __shared__ __attribute__((aligned(16))) unsigned char lds_raw[];
    LAS unsigned char* lds = (LAS unsigned char*)lds_raw;
    const int tid = threadIdx.x, lane = tid & 63, wave = __builtin_amdgcn_readfirstlane(tid >> 6);
    int lo, hi; XcdBarrier xbar;
    { KP P = kargs(); lo = P->ph_lo; hi = P->ph_hi;
      volatile LAS unsigned* bst = (volatile LAS unsigned*)(lds + 147456);
      if (tid == 0) { bst[0] = 0u; bst[1] = 0u; }
      __syncthreads();
      xbar = xcd_barrier_post((unsigned*)(P->ws + WS_BAR), bst); }
#define IN(k) (lo <= (k) && (k) < hi)
#define SEAM(k) do { if (IN(k) && IN((k) + 1)) { xcd_barrier(xbar); } } while (0)
    if (hi > NPHASE + 1) cg::this_grid().sync();
    if (IN(0)) { KP P = kargs(); p0_ada(P, lds, tid, lane, wave); }
    SEAM(0);
    const bool defer = gridDim.x == 256;
    if (IN(1)) { KP P = kargs(); convert_job(P, lds, tid, lane, wave, defer ? 2 : 31, (int)blockIdx.x, (int)gridDim.x); }
    if (IN(1)) { KP P = kargs(); unsigned char* ws = P->ws; norm_phase(P->in[0], P->in[1], P->in[6], (const float*)(ws + WS_MODS), 0, 1024, (bf16*)(ws + WS_XM), lane, wave); }
    SEAM(1);
    if (IN(2)) {
        KP P = kargs(); unsigned char* ws = P->ws;
        pg8::Gemm g{(const bf16*)(ws + WS_XM), (const bf16*)(ws + WS_W1T), NTOK, NIN, 1024}; pg8::StaticOrder S; S.init(NTOK, NIN, (int)gridDim.x, (int)blockIdx.x);
        pg8::EpiIn E{ws, P->out, P->in[11], P->in[12]};
        pg8::gemm_phase<pg8::EpiIn, pg8::StaticOrder, true, true>(lds, g, S, E);
    }
    if (IN(2) && defer && blockIdx.x >= 192) { KP P = kargs(); convert_job(P, lds, tid, lane, wave, 1 | 4, (int)blockIdx.x - 192, 64); }
    SEAM(2);
    if (IN(3)) { KP P = kargs(); sgu_phase(P, lds, tid, lane, wave); attn_phase(P, lds, tid, lane, wave); }
    SEAM(3);
    if (IN(4)) {
        KP P = kargs(); unsigned char* ws = P->ws;
        pg8::Gemm g{(const bf16*)(ws + WS_XM), (const bf16*)(ws + WS_W2T), NTOK, 1024, 1024}; pg8::StaticOrder S; S.init(NTOK, 1024, (int)gridDim.x, (int)blockIdx.x);
        pg8::EpiRes E{P->in[0], P->in[1], P->out + OUT_Y, (const float*)(ws + WS_MODS) + 2048};
        pg8::gemm_phase<pg8::EpiRes, pg8::StaticOrder, true, true>(lds, g, S, E);
    }
    if (IN(4) && defer && blockIdx.x >= 128) { KP P = kargs(); convert_job(P, lds, tid, lane, wave, 8 | 16, (int)blockIdx.x - 128, 128); }
    SEAM(4);
    if (IN(5)) { KP P = kargs(); unsigned char* ws = P->ws; float* out = P->out; norm_phase(out + OUT_Y, out + OUT_Y + (size_t)NPROMPT * DM, P->in[7], (const float*)(ws + WS_MODS), 3072, 4096, (bf16*)(ws + WS_XM), lane, wave); }
    SEAM(5);
    if (IN(6)) {
        KP P = kargs(); unsigned char* ws = P->ws;
        pg8::Gemm g{(const bf16*)(ws + WS_XM), (const bf16*)(ws + WS_W3T), NTOK, 2 * DFF, 1024}; pg8::StaticOrder S; S.init(NTOK, 2 * DFF, (int)gridDim.x, (int)blockIdx.x);
        pg8::EpiSwiglu E{(bf16*)(ws + WS_HID)};
        pg8::gemm_phase<pg8::EpiSwiglu, pg8::StaticOrder, true, true>(lds, g, S, E);
    }
    SEAM(6);
    if (IN(7)) {
        KP P = kargs(); unsigned char* ws = P->ws; float* out = P->out;
        pg8::Gemm g{(const bf16*)(ws + WS_HID), (const bf16*)(ws + WS_W4T), NTOK, 1024, DFF}; pg8::StaticOrder S; S.init(NTOK, 1024, (int)gridDim.x, (int)blockIdx.x);
        pg8::EpiRes E{out + OUT_Y, out + OUT_Y + (size_t)NPROMPT * DM, out + OUT_Y, (const float*)(ws + WS_MODS) + 5120};
        pg8::gemm_phase<pg8::EpiRes, pg8::StaticOrder, true, true>(lds, g, S, E);
    }
#undef IN
#undef SEAM
}

extern "C" void kernel_launch(void* const* d_in, const int* in_sizes, int n_in, void* d_out, int out_size, void* d_ws, size_t ws_size, hipStream_t stream) {
    static int grid = 0;
    if (grid == 0) {
        if (n_in != 25 || ws_size < WS_END) { fprintf(stderr, "kernel_launch: built for 25 inputs and >= %zu bytes of workspace; got %d, %zu\n", (size_t)WS_END, n_in, ws_size); grid = -1; return; }
        int dev = 0, cus = 0, per_cu = 0;
        if (hipGetDevice(&dev) != hipSuccess || hipDeviceGetAttribute(&cus, hipDeviceAttributeMultiprocessorCount, dev) != hipSuccess) { grid = -1; return; }
        if (hipFuncSetAttribute((const void*)fwd_megakernel, hipFuncAttributeMaxDynamicSharedMemorySize, LDS_BYTES) != hipSuccess) { fprintf(stderr, "kernel_launch: hipFuncSetAttribute failed\n"); grid = -1; return; }
        if (hipOccupancyMaxActiveBlocksPerMultiprocessor(&per_cu, (const void*)fwd_megakernel, 512, LDS_BYTES) != hipSuccess || per_cu < 1) { fprintf(stderr, "kernel_launch: occupancy query says %d\n", per_cu); per_cu = 1; }
        (void)hipGetLastError();
        grid = cus * per_cu;
    }
    if (grid < 0) return;
    if (hipMemsetAsync((char*)d_ws + WS_BAR, 0, XCD_BAR_WORDS * 4, stream) != hipSuccess) { fprintf(stderr, "kernel_launch: hipMemsetAsync failed\n"); return; }
    Params p{};
    for (int i = 0; i < 25; ++i) p.in[i] = (const float*)d_in[i];
    p.out = (float*)d_out; p.ws = (unsigned char*)d_ws;
#if MK_N_LAUNCHES == 1
    p.ph_lo = 0; p.ph_hi = NPHASE;
    void* args[] = {&p};
    hipError_t e = hipLaunchCooperativeKernel((const void*)fwd_megakernel, dim3(grid), dim3(512), args, LDS_BYTES, stream);
    if (e != hipSuccess) fprintf(stderr, "kernel_launch: cooperative launch failed: %s (grid %d)\n", hipGetErrorString(e), grid);
#else
    for (int k = 0; k < NPHASE; ++k) {
        p.ph_lo = k; p.ph_hi = k + 1;
        hipLaunchKernelGGL(fwd_megakernel, dim3(grid), dim3(512), LDS_BYTES, stream, p);
    }
#endif
}
```

```cpp
#include <hip/hip_runtime.h>
#include <hip/hip_cooperative_groups.h>
#include <cstdio>
#include <cstdint>
namespace cg = cooperative_groups;

#ifndef MK_N_LAUNCHES
#define MK_N_LAUNCHES 1
#endif

typedef unsigned short bf16;
constexpr int NTOK = 24576, NPROMPT = 8192, DM = 1024, DFF = 2816, NIN = 2560;
constexpr size_t MiB = 1u << 20;
constexpr size_t WS_MODS = 0, WS_ROPEC = 256 * 1024, WS_ROPES = 260 * 1024, WS_SSQ = 512 * 1024;
constexpr size_t WS_W1T = 1 * MiB, WS_W2T = 6 * MiB, WS_W3T = 8 * MiB, WS_W4T = 19 * MiB;
constexpr size_t WS_XM = 25 * MiB;
constexpr size_t WS_A = 73 * MiB;
constexpr size_t WS_QP = WS_A, WS_QS = WS_A + 8 * MiB, WS_KP = WS_A + 24 * MiB, WS_KS = WS_A + 32 * MiB;
constexpr size_t WS_VTP = WS_A + 52 * MiB, WS_VTS = WS_A + 60 * MiB, WS_U = WS_A + 80 * MiB, WS_GVTP = WS_A + 104 * MiB, WS_GVTS = WS_A + 112 * MiB;
constexpr size_t WS_HID = WS_A, WS_END = WS_A + 132 * MiB;
static_assert(WS_GVTS + 16 * MiB <= WS_END && WS_END <= 256 * MiB, "workspace map");
constexpr size_t OUT_Y = 0, OUT_STK = (size_t)NTOK * DM, OUT_STV = OUT_STK + 4194304;

namespace pg8 {
#define PG8_LAS __attribute__((address_space(3)))
typedef unsigned short bf16_t;
typedef short bf16x8 __attribute__((ext_vector_type(8)));
typedef float f32x4 __attribute__((ext_vector_type(4)));
typedef unsigned u32x4 __attribute__((ext_vector_type(4)));
constexpr int BM = 256, BK = 64, HALF = 128, HTB = HALF * BK * 2  , STAGE_BYTES = 8 * HTB, NXCD = 8, WGM = 8;

__host__ __device__ __forceinline__ int lds_byte(int r, int c) { const int st = (r >> 4) * 2 + (c >> 5), rr = r & 15, cc = c & 31, ob = rr * 64 + cc * 2; return st * 1024 + (ob ^ (((ob >> 9) & 1) << 5)); }
__host__ __device__ __forceinline__ void stage_rc(int b, int& R, int& C) { const int st = b / 1024, sb = b % 1024, swz = sb ^ (((sb >> 9) & 1) << 5); R = (st >> 1) * 16 + swz / 64; C = (st & 1) * 32 + (swz % 64) / 2; }
__host__ __device__ __forceinline__ int perm32(int rho) { const int n = rho >> 4, i = rho & 15; return 8 * (i >> 2) + 4 * n + (i & 3); }

struct Unit { int pm, pn; };
struct Gemm { const bf16_t* A; const bf16_t* Bt; int M, N, K; };

struct StaticOrder {
    int nM, nN, nwg, G, c;
    __host__ __device__ void init(int M, int N, int G_, int c_) { nM = M / BM; nN = N / BM; nwg = nM * nN; G = G_; c = c_; }
    __host__ __device__ bool next(int i, Unit& u) const {
        const long L = (long)i * G + c; if (L >= nwg) return false;
        int wgid = (int)L; { const int q = nwg / NXCD, r = nwg % NXCD, xcd = wgid % NXCD, off = wgid / NXCD; wgid = (xcd < r ? xcd * (q + 1) : r * (q + 1) + (xcd - r) * q) + off; }
        const int nig = WGM * nN, gid = wgid / nig, fm = gid * WGM, gsz = (nM - fm) < WGM ? (nM - fm) : WGM;
        u.pm = fm + ((wgid % nig) % gsz); u.pn = (wgid % nig) / gsz; return true;
    }
    __device__ __forceinline__ void a_ready(const Unit&) const {}
    __device__ __forceinline__ void done(const Unit&) const {}
};

__device__ __forceinline__ unsigned cvt_pk_bf16(float lo, float hi) { unsigned r; asm volatile("v_cvt_pk_bf16_f32 %0, %1, %2" : "=v"(r) : "v"(lo), "v"(hi)); return r; }
typedef float f32x2 __attribute__((ext_vector_type(2)));
typedef unsigned u32x2 __attribute__((ext_vector_type(2)));
__device__ __forceinline__ u32x2 pack4(const f32x4 v) { u32x2 w; w.x = cvt_pk_bf16(v[0], v[1]); w.y = cvt_pk_bf16(v[2], v[3]); return w; }
__device__ __forceinline__ bf16_t bf1(float v) { return (bf16_t)(cvt_pk_bf16(v, 0.f) & 0xffffu); }

struct EpiIn {
    static constexpr bool PERM = false, AFTER_DRAIN = false;
    unsigned char* ws; float* out; const float *qg, *kg;
    __device__ __forceinline__ void operator()(const f32x4 (&acc)[2][2][4][2], const Unit& u, int wr, int wc, int fr, int fq) const {
        asm volatile("" : "+v"(fr), "+v"(fq));
        const int pm = u.pm, pn = u.pn;
        const bool prompt = pm < 32;
        const int b = prompt ? pm : ((pm - 32) >> 3);
        const int s0 = prompt ? 0 : (((pm - 32) & 7) << 8);
        const int kind = pn >> 1;
        const int chw = ((pn & 1) << 8) + (wc << 6);
        if (kind <= 1) {
            const int hm = chw >> 6;
            const float* gain = kind == 0 ? qg : kg;
            f32x4 g4[2][2];
#pragma unroll
            for (int bj = 0; bj < 2; ++bj)
#pragma unroll
                for (int n = 0; n < 2; ++n) g4[bj][n] = *(const f32x4*)(gain + 32 * bj + 16 * n + 4 * fq);
            const int Sx = prompt ? 256 : (kind == 0 ? 2048 : 2560);
            bf16_t* dst = (bf16_t*)(ws + (kind == 0 ? (prompt ? WS_QP : WS_QS) : (prompt ? WS_KP : WS_KS))) + ((size_t)(b * 8 + hm) * Sx + s0) * 64 + 4 * fq;
            float* dstK = out + OUT_STK + ((size_t)(b * 8 + hm) * 256) * 64 + 4 * fq;
#pragma unroll
            for (int ai = 0; ai < 2; ++ai)
#pragma unroll
                for (int m = 0; m < 4; ++m) {
                    const int rl = ai * 128 + wr * 64 + m * 16 + fr;
                    f32x4 v[2][2]; float ss = 0.f;
#pragma unroll
                    for (int bj = 0; bj < 2; ++bj)
#pragma unroll
                        for (int n = 0; n < 2; ++n) { v[bj][n] = acc[ai][bj][m][n]; const f32x4 q = v[bj][n] * v[bj][n]; ss += (q[0] + q[1]) + (q[2] + q[3]); }
                    ss += __shfl_xor(ss, 16); ss += __shfl_xor(ss, 32);
                    const float rstd = rsqrtf(ss * (1.0f / 64.0f) + 1e-6f);
#pragma unroll
                    for (int bj = 0; bj < 2; ++bj)
#pragma unroll
                        for (int n = 0; n < 2; ++n) v[bj][n] = v[bj][n] * rstd * g4[bj][n];
                    if (!prompt) {
                        const int gr = (s0 >> 6) + 2 * ai + wr, gc = 16 * m + fr;
#pragma unroll
                        for (int bj = 0; bj < 2; ++bj) {
                            const int pos = bj == 0 ? gr : gc;
                            const f32x4 c4 = *(const f32x4*)((const float*)(ws + WS_ROPEC) + pos * 16 + 4 * fq), s4 = *(const f32x4*)((const float*)(ws + WS_ROPES) + pos * 16 + 4 * fq);
                            const f32x4 a1 = v[bj][0], a2 = v[bj][1];
                            v[bj][0] = a1 * c4 - a2 * s4; v[bj][1] = a2 * c4 + a1 * s4;
                        }
                    }
#pragma unroll
                    for (int bj = 0; bj < 2; ++bj)
#pragma unroll
                        for (int n = 0; n < 2; ++n) *(u32x2*)(dst + (size_t)rl * 64 + 32 * bj + 16 * n) = pack4(v[bj][n]);
                    if (prompt && kind == 1) {
#pragma unroll
                        for (int bj = 0; bj < 2; ++bj)
#pragma unroll
                            for (int n = 0; n < 2; ++n) __builtin_nontemporal_store(v[bj][n], (f32x4*)(dstK + (size_t)rl * 64 + 32 * bj + 16 * n));
                    }
                    asm volatile("" ::: "memory");
                }
        } else if (kind == 3) {
            bf16_t* dst = (bf16_t*)(ws + WS_U) + (size_t)(pm * 256) * 512 + chw + 4 * fq;
#pragma unroll
            for (int ai = 0; ai < 2; ++ai)
#pragma unroll
                for (int m = 0; m < 4; ++m) {
                    const int rl = ai * 128 + wr * 64 + m * 16 + fr;
#pragma unroll
                    for (int bj = 0; bj < 2; ++bj)
#pragma unroll
                        for (int n = 0; n < 2; ++n) *(u32x2*)(dst + (size_t)rl * 512 + 32 * bj + 16 * n) = pack4(acc[ai][bj][m][n]);
                    asm volatile("" ::: "memory");
                }
        } else {
            const int Sx = prompt ? 256 : (kind == 2 ? 2560 : 2048);
            bf16_t* dst = (bf16_t*)(ws + (kind == 2 ? (prompt ? WS_VTP : WS_VTS) : (prompt ? WS_GVTP : WS_GVTS))) + ((size_t)b * 512 + chw) * Sx + s0;
            float* dstV = out + OUT_STV + ((size_t)(b * 4 + (chw >> 7)) * 256) * 128 + (chw & 127);
            float* dq = (float*)(ws + WS_SSQ) + (size_t)(pm * 256) * 4 + (chw >> 7);
            const unsigned lo = (unsigned)(4 * fq) * (unsigned)Sx + (unsigned)(wr * 64 + fr);
#pragma unroll
            for (int ai = 0; ai < 2; ++ai)
#pragma unroll
                for (int m = 0; m < 4; ++m) {
                    const int rl = ai * 128 + wr * 64 + m * 16 + fr;
                    float ss = 0.f;
#pragma unroll
                    for (int bj = 0; bj < 2; ++bj)
#pragma unroll
                        for (int n = 0; n < 2; ++n) {
                            const f32x4 v = acc[ai][bj][m][n]; const int co = 32 * bj + 16 * n;
                            bf16_t* dc = dst + (size_t)co * Sx + (ai * 128 + m * 16);
#pragma unroll
                            for (int j = 0; j < 4; ++j) dc[lo + (unsigned)j * (unsigned)Sx] = bf1(v[j]);
                            if (kind == 2 && prompt) __builtin_nontemporal_store(v, (f32x4*)(dstV + (size_t)rl * 128 + co + 4 * fq));
                            const f32x4 q = v * v; ss += (q[0] + q[1]) + (q[2] + q[3]);
                        }
                    if (kind == 4) {
                        ss += __shfl_xor(ss, 16); ss += __shfl_xor(ss, 32);
                        if (fq == 0) atomicAdd(dq + (size_t)rl * 4, ss);
                    }
                    asm volatile("" ::: "memory");
                }
        }
    }
};

struct EpiRes {
    static constexpr bool PERM = false, AFTER_DRAIN = false;
    const float *base_p, *base_s; float* out; const float* gate; bool final_out;
    __device__ __forceinline__ void operator()(const f32x4 (&acc)[2][2][4][2], const Unit& u, int wr, int wc, int fr, int fq) const {
        asm volatile("" : "+v"(fr), "+v"(fq));
        const int pm = u.pm, cond = pm < 32 ? 0 : 1 + ((pm - 32) >> 3);
        const float* base = pm < 32 ? base_p + (size_t)pm * 256 * 1024 : base_s + (size_t)(pm - 32) * 256 * 1024;
        float* o = out + (size_t)pm * 256 * 1024;
        const int col0 = u.pn * 256 + wc * 32 + 4 * fq;
        f32x4 gv[2][2];
#pragma unroll
        for (int bj = 0; bj < 2; ++bj)
#pragma unroll
            for (int n = 0; n < 2; ++n) gv[bj][n] = *(const f32x4*)(gate + cond * 6144 + col0 + bj * 128 + n * 16);
#pragma unroll
        for (int ai = 0; ai < 2; ++ai) {
            f32x4 bs[4][2][2];
#pragma unroll
            for (int m = 0; m < 4; ++m) { const size_t ro = (size_t)(ai * 128 + wr * 64 + m * 16 + fr) * 1024 + col0;
#pragma unroll
                for (int bj = 0; bj < 2; ++bj)
#pragma unroll
                    for (int n = 0; n < 2; ++n) bs[m][bj][n] = __builtin_nontemporal_load((const f32x4*)(base + ro + bj * 128 + n * 16)); }
            asm volatile("" ::: "memory");
#pragma unroll
            for (int m = 0; m < 4; ++m) { const size_t ro = (size_t)(ai * 128 + wr * 64 + m * 16 + fr) * 1024 + col0;
#pragma unroll
                for (int bj = 0; bj < 2; ++bj)
#pragma unroll
                    for (int n = 0; n < 2; ++n) { const f32x4 y = bs[m][bj][n] + gv[bj][n] * acc[ai][bj][m][n]; f32x4* yp = (f32x4*)(o + ro + bj * 128 + n * 16);
                        if (final_out) __builtin_nontemporal_store(y, yp); else *yp = y; } }
            asm volatile("" ::: "memory");
        }
    }
};

struct EpiSwiglu {
    static constexpr bool PERM = false, AFTER_DRAIN = false;
    bf16_t* H;
    __device__ __forceinline__ void operator()(const f32x4 (&acc)[2][2][4][2], const Unit& u, int wr, int wc, int fr, int fq) const {
        asm volatile("" : "+v"(fr), "+v"(fq));
        bf16_t* dst = H + (size_t)(u.pm * 256) * 2816 + u.pn * 128 + wc * 32 + 4 * fq;
#pragma unroll
        for (int ai = 0; ai < 2; ++ai)
#pragma unroll
            for (int m = 0; m < 4; ++m) {
                const int rl = ai * 128 + wr * 64 + m * 16 + fr;
#pragma unroll
                for (int n = 0; n < 2; ++n) {
                    const f32x4 g = acc[ai][0][m][n], up = acc[ai][1][m][n]; f32x4 h;
#pragma unroll
                    for (int j = 0; j < 4; ++j) h[j] = g[j] * __builtin_amdgcn_rcpf(1.0f + __expf(-g[j])) * up[j];
                    *(u32x2*)(dst + (size_t)rl * 2816 + 16 * n) = pack4(h);
                }
            }
    }
};

template <class Epi, class Sched, bool ALIGN_EPI = false, bool SP2 = false>
__device__ __forceinline__ void gemm_phase(PG8_LAS unsigned char* lds, const Gemm g, const Sched& S, const Epi& E) {
    const int tid = threadIdx.x, wid = __builtin_amdgcn_readfirstlane(tid >> 6), lane = tid & 63, wr = wid >> 2, wc = wid & 3, fr = lane & 15, fq = lane >> 4;
    const int K = g.K, nt = K / BK;
    unsigned voffA[2], voffB[2];
#pragma unroll
    for (int i = 0; i < 2; ++i) { int R, C; stage_rc(tid * 16 + i * 8192, R, C); const int Rb = Epi::PERM ? ((R & ~31) + perm32(R & 31)) : R;
        voffA[i] = (unsigned)(R * K + C) * 2u; voffB[i] = (unsigned)(Rb * K + C) * 2u; }
    const size_t kstep = (size_t)(BK * 2);
    const size_t hstep = (size_t)HALF * K * 2;
    const size_t tstep = 2 * hstep;
    const unsigned ldsw = (unsigned)wid * 1024u;
    const int aoff = lds_byte(wr * 64 + fr, fq * 8), boff = lds_byte(wc * 32 + fr, fq * 8);
#define PG8_SA(b, h) (((b) * 2 + (h)) * HTB)
#define PG8_SB(b, h) ((4 + (b) * 2 + (h)) * HTB)
#define PG8_STAGE(bufoff, gbase, voff) do { _Pragma("unroll") for (int _i = 0; _i < 2; ++_i) \
        __builtin_amdgcn_global_load_lds((const unsigned*)((const char*)(gbase) + (voff)[_i]), (PG8_LAS unsigned*)(lds + (bufoff) + ldsw + _i * 8192), 16, 0, 0); } while (0)
#define PG8_LDA(dst, b, h) do { _Pragma("unroll") for (int m = 0; m < 4; ++m) _Pragma("unroll") for (int k = 0; k < 2; ++k) dst[m][k] = *(const PG8_LAS bf16x8*)(lds + PG8_SA(b, h) + aoff + m * 2048 + k * 1024); } while (0)
#define PG8_LDB(dst, b, h) do { _Pragma("unroll") for (int n = 0; n < 2; ++n) _Pragma("unroll") for (int k = 0; k < 2; ++k) dst[n][k] = *(const PG8_LAS bf16x8*)(lds + PG8_SB(b, h) + boff + n * 2048 + k * 1024); } while (0)
#define PG8_MMA(ai, bj, At, Bt) do { __builtin_amdgcn_s_setprio(1); _Pragma("unroll") for (int m = 0; m < 4; ++m) _Pragma("unroll") for (int n = 0; n < 2; ++n) _Pragma("unroll") for (int k = 0; k < 2; ++k) \
        acc[ai][bj][m][n] = __builtin_amdgcn_mfma_f32_16x16x32_bf16(Bt[n][k], At[m][k], acc[ai][bj][m][n], 0, 0, 0); __builtin_amdgcn_s_setprio(0); } while (0)
#define PG8_WAIT_V(n) asm volatile("s_waitcnt vmcnt(" #n ")" ::: "memory")
#define PG8_WAIT_L(n) asm volatile("s_waitcnt lgkmcnt(" #n ")" ::: "memory")
#define PG8_BAR __builtin_amdgcn_s_barrier()
#define PG8_SCHED __builtin_amdgcn_sched_barrier(0)
    Unit cur, nxt; int ui = 0;
    if (!S.next(0, cur)) return;
    f32x4 acc[2][2][4][2];
#pragma unroll
    for (int a = 0; a < 2; ++a)
#pragma unroll
        for (int b = 0; b < 2; ++b)
#pragma unroll
            for (int m = 0; m < 4; ++m)
#pragma unroll
                for (int n = 0; n < 2; ++n) acc[a][b][m][n] = (f32x4){0.f, 0.f, 0.f, 0.f};
    bf16x8 At[4][2], B0[2][2], B1[2][2];
    const char* cA = (const char*)g.A + (size_t)cur.pm * tstep; const char* cB = (const char*)g.Bt + (size_t)cur.pn * tstep;
    S.a_ready(cur);
    if constexpr (SP2) {
        PG8_STAGE(PG8_SB(0, 0), cB, voffB); PG8_STAGE(PG8_SB(0, 1), cB + hstep, voffB); PG8_STAGE(PG8_SA(0, 0), cA, voffA); PG8_STAGE(PG8_SA(0, 1), cA + hstep, voffA);
        if (wr == 1) PG8_BAR;
        PG8_WAIT_V(2); PG8_BAR;
        PG8_STAGE(PG8_SB(1, 0), cB + kstep, voffB); PG8_STAGE(PG8_SA(1, 0), cA + kstep, voffA); PG8_STAGE(PG8_SB(1, 1), cB + hstep + kstep, voffB);
        PG8_WAIT_V(6); PG8_BAR;
    } else {
        PG8_STAGE(PG8_SB(0, 0), cB, voffB); PG8_STAGE(PG8_SA(0, 0), cA, voffA); PG8_STAGE(PG8_SB(0, 1), cB + hstep, voffB); PG8_STAGE(PG8_SA(0, 1), cA + hstep, voffA);
        if (wr == 1) PG8_BAR;
        PG8_WAIT_V(4); PG8_BAR;
        PG8_STAGE(PG8_SB(1, 0), cB + kstep, voffB); PG8_STAGE(PG8_SA(1, 0), cA + kstep, voffA); PG8_STAGE(PG8_SB(1, 1), cB + hstep + kstep, voffB);
        PG8_WAIT_V(6); PG8_BAR;
    }
    for (;;) {
        const bool has_next = S.next(ui + 1, nxt);
        const char* nA = has_next ? (const char*)g.A + (size_t)nxt.pm * tstep : cA; const char* nB = has_next ? (const char*)g.Bt + (size_t)nxt.pn * tstep : cB;
        for (int t = 0; t < nt; t += 2) {
            const bool last = (t == nt - 2);
            const char* a1 = cA + (size_t)(t + 1) * kstep;
            const char* a2 = last ? nA : cA + (size_t)(t + 2) * kstep; const char* b2 = last ? nB : cB + (size_t)(t + 2) * kstep;
            const char* a3 = a2 + kstep; const char* b3 = b2 + kstep;
            if (last && has_next) S.a_ready(nxt);
            if constexpr (SP2) {
            PG8_LDB(B0, 0, 0); PG8_LDB(B1, 0, 1); PG8_SCHED; PG8_LDA(At, 0, 0); PG8_STAGE(PG8_SA(1, 1), a1 + hstep, voffA);
            PG8_WAIT_V(8); PG8_WAIT_L(0); PG8_BAR; PG8_MMA(0, 0, At, B0); PG8_MMA(0, 1, At, B1); PG8_BAR; PG8_SCHED;
            PG8_LDA(At, 0, 1); PG8_STAGE(PG8_SB(0, 0), b2, voffB); PG8_STAGE(PG8_SB(0, 1), b2 + hstep, voffB); PG8_STAGE(PG8_SA(0, 0), a2, voffA);
            PG8_WAIT_V(8); PG8_WAIT_L(0); PG8_BAR; PG8_MMA(1, 0, At, B0); PG8_MMA(1, 1, At, B1); PG8_BAR; PG8_SCHED;
            PG8_LDB(B0, 1, 0); PG8_LDB(B1, 1, 1); PG8_SCHED; PG8_LDA(At, 1, 0); PG8_STAGE(PG8_SA(0, 1), a2 + hstep, voffA);
            PG8_WAIT_V(8); PG8_WAIT_L(0); PG8_BAR; PG8_MMA(0, 0, At, B0); PG8_MMA(0, 1, At, B1); PG8_BAR; PG8_SCHED;
            PG8_LDA(At, 1, 1); PG8_STAGE(PG8_SB(1, 0), b3, voffB); PG8_STAGE(PG8_SB(1, 1), b3 + hstep, voffB); PG8_STAGE(PG8_SA(1, 0), a3, voffA);
            PG8_WAIT_V(8); PG8_WAIT_L(0); PG8_BAR; PG8_MMA(1, 0, At, B0); PG8_MMA(1, 1, At, B1); PG8_BAR; PG8_SCHED;
            } else {
            PG8_LDB(B0, 0, 0); PG8_SCHED; PG8_LDA(At, 0, 0); PG8_STAGE(PG8_SA(1, 1), a1 + hstep, voffA);
            PG8_WAIT_L(8); PG8_BAR; PG8_WAIT_L(0); PG8_MMA(0, 0, At, B0); PG8_BAR; PG8_SCHED;
            PG8_LDB(B1, 0, 1); PG8_STAGE(PG8_SB(0, 0), b2, voffB);
            PG8_BAR; PG8_WAIT_L(0); PG8_MMA(0, 1, At, B1); PG8_BAR;
            PG8_LDA(At, 0, 1); PG8_STAGE(PG8_SA(0, 0), a2, voffA);
            PG8_BAR; PG8_WAIT_L(0); PG8_MMA(1, 0, At, B0); PG8_BAR; PG8_SCHED;
            PG8_STAGE(PG8_SB(0, 1), b2 + hstep, voffB);
            PG8_WAIT_V(6); PG8_BAR; PG8_MMA(1, 1, At, B1); PG8_BAR;
            PG8_LDB(B0, 1, 0); PG8_SCHED; PG8_LDA(At, 1, 0); PG8_STAGE(PG8_SA(0, 1), a2 + hstep, voffA);
            PG8_WAIT_L(8); PG8_BAR; PG8_WAIT_L(0); PG8_MMA(0, 0, At, B0); PG8_BAR; PG8_SCHED;
            PG8_LDB(B1, 1, 1); PG8_STAGE(PG8_SB(1, 0), b3, voffB);
            PG8_BAR; PG8_WAIT_L(0); PG8_MMA(0, 1, At, B1); PG8_BAR;
            PG8_LDA(At, 1, 1); PG8_STAGE(PG8_SA(1, 0), a3, voffA);
            PG8_BAR; PG8_WAIT_L(0); PG8_MMA(1, 0, At, B0); PG8_BAR; PG8_SCHED;
            PG8_STAGE(PG8_SB(1, 1), b3 + hstep, voffB);
            PG8_WAIT_V(6); PG8_BAR; PG8_MMA(1, 1, At, B1); PG8_BAR;
            }
        }
        if constexpr (ALIGN_EPI) { if (wr == 0) PG8_BAR; }
        if constexpr (!Epi::AFTER_DRAIN) { E(acc, cur, wr, wc, fr, fq); S.done(cur); }
        if (!has_next) break;
#pragma unroll
        for (int a = 0; a < 2; ++a)
#pragma unroll
            for (int b = 0; b < 2; ++b)
#pragma unroll
                for (int m = 0; m < 4; ++m)
#pragma unroll
                    for (int n = 0; n < 2; ++n) acc[a][b][m][n] = (f32x4){0.f, 0.f, 0.f, 0.f};
        cur = nxt; cA = nA; cB = nB; ++ui;
        if constexpr (ALIGN_EPI) { if (wr == 1) PG8_BAR; }
    }
    PG8_WAIT_V(0);
    if constexpr (!ALIGN_EPI) { if (wr == 0) PG8_BAR; }
    PG8_BAR;
    if constexpr (Epi::AFTER_DRAIN) { E.fused(acc, cur, wr, wc, fr, fq, lds, wid, lane); S.done(cur); }
#undef PG8_SA
#undef PG8_SB
#undef PG8_STAGE
#undef PG8_LDA
#undef PG8_LDB
#undef PG8_MMA
#undef PG8_WAIT_V
#undef PG8_WAIT_L
#undef PG8_BAR
#undef PG8_SCHED
}
}

#define LAS __attribute__((address_space(3)))
typedef float f32x4 __attribute__((ext_vector_type(4)));
typedef float f32x16 __attribute__((ext_vector_type(16)));
typedef short bf16x8 __attribute__((ext_vector_type(8)));
typedef unsigned u32x4 __attribute__((ext_vector_type(4)));
typedef unsigned u32x2 __attribute__((ext_vector_type(2)));

constexpr int LDS_BYTES = 147456 + 256;
constexpr size_t WS_BAR = 900 * 1024;
constexpr int NPHASE = 8;

struct Params { const float* in[25]; float* out; unsigned char* ws; int ph_lo, ph_hi; };
typedef const __attribute__((address_space(4))) Params* KP;
__device__ __forceinline__ KP kargs() { unsigned long long k = (unsigned long long)__builtin_amdgcn_kernarg_segment_ptr(); asm volatile("" : "+s"(k)); return (KP)k; }

__device__ __forceinline__ float wave_sum(float v) {
#pragma unroll
    for (int o = 1; o < 64; o <<= 1) v += __shfl_xor(v, o);
    return v;
}
__device__ __forceinline__ unsigned pk2(float lo, float hi) { return pg8::cvt_pk_bf16(lo, hi); }

__device__ __forceinline__ void sincos_small(float x, float& s, float& c) {
    const float k = rintf(x * 0.636619772367581343f);
    float r = fmaf(-k, 1.57079601287841796875f, x);
    r = fmaf(-k, 3.1391647326017846e-7f, r);
    r = fmaf(-k, 5.3903025299577648e-15f, r);
    const float r2 = r * r;
    float sp = fmaf(r2, 2.7183114939898219064e-6f, -1.9839334836096632576e-4f); sp = fmaf(sp, r2, 8.3333293858894631756e-3f); sp = fmaf(sp, r2, -1.6666665896820998054e-1f);
    const float sn = fmaf(r * r2, sp, r);
    float cp = fmaf(r2, 2.4433157118340246e-5f, -1.3887316255899256e-3f); cp = fmaf(cp, r2, 4.1666645655422476e-2f); cp = fmaf(cp, r2, -0.5f);
    const float cs = fmaf(cp, r2, 1.0f);
    const int q = ((int)k) & 3;
    const float s0 = (q & 1) ? cs : sn, c0 = (q & 1) ? sn : cs;
    s = (q & 2) ? -s0 : s0;
    c = ((q + 1) & 2) ? -c0 : c0;
}

template <int MAP>
__device__ __forceinline__ int dest_row(int n0) {
    if (MAP == 1) { const int pn = n0 >> 8, x = n0 & 255, wc = x >> 6, bj = (x >> 5) & 1; return (pn << 8) + (bj << 7) + (wc << 5); }
    if (MAP == 2) { const int bj = n0 >= DFF ? 1 : 0, rem = n0 - bj * DFF, pn = rem >> 7, x = rem & 127; return (pn << 8) + (bj << 7) + x; }
    return n0;
}
template <int MAP>
__device__ __forceinline__ void p0_transpose_item(const float* W, int K, int N, bf16* WT, LAS float* scr, int item, int lane) {
    const int nblk = N / 32, kb = item / nblk, nb = item % nblk, k0 = 64 * kb, n0 = 32 * nb;
    float wv[32];
#pragma unroll
    for (int i = 0; i < 32; ++i) wv[i] = __builtin_nontemporal_load(W + (size_t)(k0 + 2 * i + (lane >> 5)) * N + n0 + (lane & 31));
#pragma unroll
    for (int i = 0; i < 32; ++i) scr[(2 * i + (lane >> 5)) * 33 + (lane & 31)] = wv[i];
    asm volatile("s_waitcnt lgkmcnt(0)" ::: "memory");
    const int c = lane & 7; const int dr = dest_row<MAP>(n0);
#pragma unroll
    for (int j = 0; j < 4; ++j) { const int n = (lane >> 3) + 8 * j; const LAS float* s = scr + (8 * c) * 33 + n;
        u32x4 o; o.x = pk2(s[0 * 33], s[1 * 33]); o.y = pk2(s[2 * 33], s[3 * 33]); o.z = pk2(s[4 * 33], s[5 * 33]); o.w = pk2(s[6 * 33], s[7 * 33]);
        *(u32x4*)(WT + (size_t)(dr + n) * K + k0 + 8 * c) = o; }
    asm volatile("s_waitcnt lgkmcnt(0)" ::: "memory");
}

__device__ __forceinline__ void p0_ada(KP P, LAS unsigned char* lds, int tid, int lane, int wave) {
    unsigned char* ws = P->ws;
    const int G = gridDim.x, bx = blockIdx.x;
    const int gt = bx * 512 + tid, NGT = G * 512;
    for (int i = gt; i < NTOK; i += NGT) ((f32x4*)(ws + WS_SSQ))[i] = (f32x4){0.f, 0.f, 0.f, 0.f};
    if (bx == G - 1) {
        for (int i = tid; i < 1024; i += 512) {
            const int pos = i >> 4, f = i & 15;
            const float inv = exp2f(-(float)(2 * f) * (1.0f / 32.0f) * 13.287712379549449f);
            float s, c; sincos_small((float)pos * inv, s, c);
            ((float*)(ws + WS_ROPEC))[i] = c; ((float*)(ws + WS_ROPES))[i] = s;
        }
    }
    LAS float* scond = (LAS float*)lds;
    LAS float* red = (LAS float*)(lds + 36864);
    const float* wada = P->in[8]; const float* bada = P->in[9]; float* mods = (float*)(ws + WS_MODS);
    bool have = false;
    for (int it = bx; it < 192; it += G) {
        const int n0 = it * 32, c4 = (lane & 7) * 4, rg = lane >> 3, kbase = wave * 128 + rg;
        f32x4 w[16];
#pragma unroll
        for (int i = 0; i < 16; ++i) w[i] = __builtin_nontemporal_load((const f32x4*)(wada + (size_t)(kbase + 8 * i) * 6144 + n0 + c4));
        if (!have) {
            for (int idx = tid; idx < 9216; idx += 512) { const int c = idx >> 10, k = idx & 1023; const float x = c == 0 ? P->in[5][k] : P->in[4][(c - 1) * 1024 + k]; scond[idx] = x / (1.0f + __expf(-x)); }
            have = true;
        }
        __syncthreads();
        f32x4 a[9];
#pragma unroll
        for (int c = 0; c < 9; ++c) a[c] = (f32x4){0.f, 0.f, 0.f, 0.f};
#pragma unroll
        for (int i = 0; i < 16; ++i) {
#pragma unroll
            for (int c = 0; c < 9; ++c) a[c] += w[i] * scond[c * 1024 + kbase + 8 * i]; }
#pragma unroll
        for (int c = 0; c < 9; ++c)
#pragma unroll
            for (int j = 0; j < 4; ++j) { float v = a[c][j]; v += __shfl_xor(v, 8); v += __shfl_xor(v, 16); v += __shfl_xor(v, 32); a[c][j] = v; }
        if (lane < 8) {
#pragma unroll
            for (int c = 0; c < 9; ++c) *(LAS f32x4*)(red + (wave * 9 + c) * 32 + c4) = a[c]; }
        __syncthreads();
        if (tid < 288) { const int c = tid >> 5, cl = tid & 31; float s = 0.f;
#pragma unroll
            for (int p = 0; p < 8; ++p) s += red[(p * 9 + c) * 32 + cl];
            mods[c * 6144 + n0 + cl] = s + bada[n0 + cl]; }
    }
    __syncthreads();
}

__device__ __forceinline__ void convert_job(KP P, LAS unsigned char* lds, int tid, int lane, int wave, int what, int rank, int nblk) {
    unsigned char* ws = P->ws;
    const int gt = rank * 512 + tid, NGT = nblk * 512;
    if (what & 1) {
        const float* ck = P->in[2]; bf16* Ks = (bf16*)(ws + WS_KS);
        for (int i = gt; i < 262144; i += NGT) {
            const int c = i & 7, s = (i >> 3) & 511, bhm = i >> 12;
            const f32x4 a = __builtin_nontemporal_load((const f32x4*)(ck + (size_t)i * 8)), b2 = __builtin_nontemporal_load((const f32x4*)(ck + (size_t)i * 8 + 4));
            u32x4 o; o.x = pk2(a[0], a[1]); o.y = pk2(a[2], a[3]); o.z = pk2(b2[0], b2[1]); o.w = pk2(b2[2], b2[3]);
            *(u32x4*)(Ks + ((size_t)bhm * 2560 + 2048 + s) * 64 + c * 8) = o;
        }
        const float* cv = P->in[3]; bf16* VTs = (bf16*)(ws + WS_VTS);
        for (int i = gt; i < 262144; i += NGT) {
            const int sc = ((i >> 10) & 7) * 8 + (i & 7), dv = (i >> 3) & 127, bh = i >> 13;
            const float* src = cv + ((size_t)bh * 512 + sc * 8) * 128 + dv;
            float v8[8];
#pragma unroll
            for (int j = 0; j < 8; ++j) v8[j] = __builtin_nontemporal_load(src + 128 * j);
            asm volatile("" ::: "memory");
            u32x4 o; o.x = pk2(v8[0], v8[1]); o.y = pk2(v8[2], v8[3]); o.z = pk2(v8[4], v8[5]); o.w = pk2(v8[6], v8[7]);
            *(u32x4*)(VTs + ((size_t)bh * 128 + dv) * 2560 + 2048 + sc * 8) = o;
        }
    }
    {
        LAS float* scr = (LAS float*)(lds + wave * 16384);
        const int gw = rank * 8 + wave, NGW = nblk * 8;
        const int I1 = (what & 2) ? 16 * 80 : 0, I2 = (what & 4) ? 16 * 32 : 0, I3 = (what & 8) ? 16 * 176 : 0, I4 = (what & 16) ? 44 * 32 : 0, NITEMS = I1 + I2 + I3 + I4;
        for (int it = gw; it < NITEMS; it += NGW) {
            int r = it;
            if (r < I1) { p0_transpose_item<1>(P->in[10], 1024, NIN, (bf16*)(ws + WS_W1T), scr, r, lane); continue; } r -= I1;
            if (r < I2) { p0_transpose_item<0>(P->in[22], 1024, 1024, (bf16*)(ws + WS_W2T), scr, r, lane); continue; } r -= I2;
            if (r < I3) { p0_transpose_item<2>(P->in[23], 1024, 2 * DFF, (bf16*)(ws + WS_W3T), scr, r, lane); continue; } r -= I3;
            p0_transpose_item<0>(P->in[24], DFF, 1024, (bf16*)(ws + WS_W4T), scr, r, lane);
        }
    }
}

__device__ __forceinline__ void norm_phase(const float* xp, const float* xs, const float* g, const float* mods, int shift_off, int scale_off, bf16* XM, int lane, int wave) {
    const int gw = blockIdx.x * 8 + wave, NGW = gridDim.x * 8;
    constexpr int R = 3;
    for (int m0 = gw * R; m0 < NTOK; m0 += NGW * R) {
        f32x4 v[R][4];
#pragma unroll
        for (int rr = 0; rr < R; ++rr) { const int m = m0 + rr;
            const float* xrow = m < NPROMPT ? xp + (size_t)m * DM : xs + (size_t)(m - NPROMPT) * DM;
            const f32x4* xr = (const f32x4*)xrow + lane;
#pragma unroll
            for (int j = 0; j < 4; ++j) v[rr][j] = __builtin_nontemporal_load(xr + 64 * j); }
#pragma unroll
        for (int rr = 0; rr < R; ++rr) { const int m = m0 + rr;
            const int cond = m < NPROMPT ? 0 : 1 + ((m - NPROMPT) >> 11);
            float s = 0.f;
#pragma unroll
            for (int j = 0; j < 4; ++j) { const f32x4 q = v[rr][j] * v[rr][j]; s += (q[0] + q[1]) + (q[2] + q[3]); }
            const float rstd = rsqrtf(wave_sum(s) * (1.0f / DM) + 1e-6f);
            const float* sh = mods + cond * 6144 + shift_off; const float* sc = mods + cond * 6144 + scale_off;
            u32x2* o8 = (u32x2*)(XM + (size_t)m * DM) + lane;
#pragma unroll
            for (int j = 0; j < 4; ++j) {
                const f32x4 gg = ((const f32x4*)g)[lane + 64 * j], s1 = ((const f32x4*)sc)[lane + 64 * j], h1 = ((const f32x4*)sh)[lane + 64 * j];
                const f32x4 y = v[rr][j] * rstd * gg * (1.0f + s1) + h1;
                u32x2 w; w.x = pk2(y[0], y[1]); w.y = pk2(y[2], y[3]); o8[64 * j] = w;
            }
        }
    }
}

__device__ __forceinline__ void sgu_phase(KP P, LAS unsigned char* lds, int tid, int lane, int wave) {
    unsigned char* ws = P->ws;
    const float* ssq = (const float*)(ws + WS_SSQ);
    const bf16* U = (const bf16*)(ws + WS_U);
    bf16* MIX = (bf16*)(ws + WS_XM);
    const float* sng = P->in[18]; const float* sw = P->in[19]; const float* sb = P->in[20]; const float* mog = P->in[21];
    const int r = lane & 31, h = lane >> 5, pb = wave & 3, ch2 = wave >> 2;
    constexpr int TP = 272;
    LAS unsigned char* A = lds;
    LAS unsigned char* B = lds + 32768;
    LAS unsigned char* UT = lds + 65536;
    LAS unsigned char* OT = lds + 65536 + 128 * TP;
    LAS float* red = (LAS float*)(lds + 65536 + 256 * TP);
    LAS float* rsq = red + 256;
    LAS float* rstv = rsq + 512;
    for (int ck = blockIdx.x; ck < 192; ck += gridDim.x) {
        const bool prompt = ck < 64;
        const int b = prompt ? (ck >> 1) : ((ck - 64) >> 4), s0 = prompt ? ((ck & 1) << 7) : (((ck - 64) & 15) << 7), Sx = prompt ? 256 : 2048;
        const bf16* GVT = prompt ? (const bf16*)(ws + WS_GVTP) : (const bf16*)(ws + WS_GVTS);
        const int tok0 = ck * 128;
        __syncthreads();
        { const int q = tid >> 2, g = tid & 3; rsq[g * 128 + q] = rsqrtf(ssq[(size_t)(tok0 + q) * 4 + g] * (1.0f / 128.0f) + 1e-6f); }
        const int p = pb * 32 + r;
        float ss = 0.f;
#pragma unroll 1
        for (int g = 0; g < 4; ++g) {
            __syncthreads();
#pragma unroll
            for (int i = 0; i < 4; ++i) { const int q = tid + 512 * i, c = q >> 4, cc = q & 15;
                const u32x4 v = __builtin_nontemporal_load((const u32x4*)(GVT + ((size_t)b * 512 + g * 128 + c) * Sx + s0 + cc * 8));
                const u32x4 uu = __builtin_nontemporal_load((const u32x4*)(U + (size_t)(tok0 + c) * 512 + g * 128 + cc * 8));
                *(LAS u32x4*)(A + c * 256 + ((cc ^ (c & 15)) << 4)) = v;
                *(LAS u32x4*)(UT + c * TP + cc * 16) = uu; }
            asm volatile("" ::: "memory");
#pragma unroll
            for (int i = 0; i < 8; ++i) { const int idx = tid + 512 * i, pp = idx >> 5, q4 = (idx & 31) << 2;
                const f32x4 w = *(const f32x4*)(sw + (size_t)g * 16384 + pp * 128 + q4);
                const f32x4 rs = *(const LAS f32x4*)(rsq + g * 128 + q4);
                const f32x4 y = w * rs; u32x2 o; o.x = pk2(y[0], y[1]); o.y = pk2(y[2], y[3]);
                const int cc = q4 >> 3;
                *(LAS u32x2*)(B + pp * 256 + ((cc ^ (pp & 15)) << 4) + ((q4 & 4) << 1)) = o;
                if (i == 3) asm volatile("" ::: "memory"); }
            __syncthreads();
            f32x16 acc[2]; acc[0] = (f32x16)(0.f); acc[1] = (f32x16)(0.f);
#pragma unroll
            for (int ks = 0; ks < 8; ++ks) {
                const bf16x8 bw = *(const LAS bf16x8*)(B + p * 256 + (((2 * ks + h) ^ (p & 15)) << 4));
#pragma unroll
                for (int t = 0; t < 2; ++t) { const int crow = (ch2 * 2 + t) * 32 + r;
                    const bf16x8 ag = *(const LAS bf16x8*)(A + crow * 256 + (((2 * ks + h) ^ (crow & 15)) << 4));
                    acc[t] = __builtin_amdgcn_mfma_f32_32x32x16_bf16(ag, bw, acc[t], 0, 0, 0); }
            }
            const float bp = sb[g * 128 + p];
#pragma unroll
            for (int t = 0; t < 2; ++t)
#pragma unroll
                for (int q = 0; q < 4; ++q) {
                    const int c = (ch2 * 2 + t) * 32 + 8 * q + 4 * h;
                    const f32x4 gn = *(const f32x4*)(sng + g * 128 + c);
                    const u32x2 uu = *(const LAS u32x2*)(UT + p * TP + c * 2);
                    float uf[4]; uf[0] = __uint_as_float(uu.x << 16); uf[1] = __uint_as_float(uu.x & 0xffff0000u); uf[2] = __uint_as_float(uu.y << 16); uf[3] = __uint_as_float(uu.y & 0xffff0000u);
                    float v[4];
#pragma unroll
                    for (int j = 0; j < 4; ++j) { v[j] = uf[j] * fmaf(gn[j], acc[t][4 * q + j], bp); ss = fmaf(v[j], v[j], ss); }
                    u32x2 o; o.x = pk2(v[0], v[1]); o.y = pk2(v[2], v[3]);
                    *(LAS u32x2*)(OT + p * TP + c * 2) = o;
                }
            __syncthreads();
#pragma unroll
            for (int i = 0; i < 4; ++i) { const int q = tid + 512 * i, row = q >> 4, cc = q & 15;
                *(u32x4*)(MIX + (size_t)(tok0 + row) * 1024 + 512 + g * 128 + cc * 8) = *(const LAS u32x4*)(OT + row * TP + cc * 16); }
        }
        ss += __shfl_xor(ss, 32);
        if (h == 0) red[ch2 * 128 + p] = ss;
        __syncthreads();
        if (tid < 128) rstv[tid] = rsqrtf((red[tid] + red[128 + tid]) * (1.0f / 512.0f) + 1e-6f);
        __syncthreads();
#pragma unroll 4
        for (int i = 0; i < 16; ++i) { const int q = tid + 512 * i, row = q >> 6, cc = q & 63;
            u32x4* mp = (u32x4*)(MIX + (size_t)(tok0 + row) * 1024 + 512 + cc * 8);
            const u32x4 x = *mp; const float rs = rstv[row];
            const f32x4 m0 = *(const f32x4*)(mog + cc * 8), m1 = *(const f32x4*)(mog + cc * 8 + 4);
            u32x4 o;
            o.x = pk2(__uint_as_float(x.x << 16) * rs * m0[0], __uint_as_float(x.x & 0xffff0000u) * rs * m0[1]);
            o.y = pk2(__uint_as_float(x.y << 16) * rs * m0[2], __uint_as_float(x.y & 0xffff0000u) * rs * m0[3]);
            o.z = pk2(__uint_as_float(x.z << 16) * rs * m1[0], __uint_as_float(x.z & 0xffff0000u) * rs * m1[1]);
            o.w = pk2(__uint_as_float(x.w << 16) * rs * m1[2], __uint_as_float(x.w & 0xffff0000u) * rs * m1[3]);
            *mp = o; }
    }
    __syncthreads();
}

__device__ __forceinline__ float max3f(float a, float b, float c) { float r; asm("v_max3_f32 %0, %1, %2, %3" : "=v"(r) : "v"(a), "v"(b), "v"(c)); return r; }
__device__ __forceinline__ void attn_unit(LAS unsigned char* lds, const bf16* Qb, int Sq, int q0, const bf16* Kb, const bf16* VTb, int Sk,
                                          bf16* mixp, const float* gout, float lam, int tid, int lane, int wave, int tmul = 1) {
    const int r = lane & 31, h = lane >> 5, qsub = wave >> 1, map = wave & 1;
    const int nt = Sk >> 6;
    bf16x8 qf[4];
    { const bf16* qp = Qb + ((size_t)map * Sq + q0 + qsub * 32 + r) * 64 + 8 * h;
#pragma unroll
      for (int ks = 0; ks < 4; ++ks) qf[ks] = *(const bf16x8*)(qp + 16 * ks); }
    const bf16* K1 = Kb; const bf16* K2 = Kb + (size_t)Sk * 64;
    const int srow = tid >> 3, sc = tid & 7;
    const int so = srow * 128 + ((sc ^ ((srow >> 1) & 7)) << 4);
    const bf16* gk1 = K1 + tid * 8; const bf16* gk2 = K2 + tid * 8;
    const bf16* gv0 = VTb + (size_t)srow * Sk + sc * 8; const bf16* gv1 = gv0 + (size_t)64 * Sk;
    const int kr = (r & 19) | ((r & 4) << 1) | ((r & 8) >> 1);
    const int kx = (h ^ ((kr >> 1) & 7)) << 4, koff = map * 8192 + kr * 128;
    const int vx = (h ^ ((r >> 1) & 7)) << 4, voff = 16384 + r * 128;
    f32x16 O[4];
#pragma unroll
    for (int i = 0; i < 4; ++i) O[i] = (f32x16)(0.f);
    float mrun = -1e30f, lsum = 0.f;
    const float C = 0.18033688011112042f;
    const float TLAZY = 8.0f / 0.18033688011112042f;
    u32x4 st0, st1, st2, st3;
    st0 = *(const u32x4*)gk1; st1 = *(const u32x4*)gk2; st2 = *(const u32x4*)gv0; st3 = *(const u32x4*)gv1;
    *(LAS u32x4*)(lds + so) = st0; *(LAS u32x4*)(lds + 8192 + so) = st1; *(LAS u32x4*)(lds + 16384 + so) = st2; *(LAS u32x4*)(lds + 24576 + so) = st3;
    __syncthreads();
    for (int t = 0; t < nt; ++t) {
        LAS unsigned char* buf = lds + ((t & 1) << 15);
        const bool p1 = t + 1 < nt;
        if (p1) { const int e = (t + 1) * tmul * 64;
            st0 = *(const u32x4*)(gk1 + (size_t)e * 64); st1 = *(const u32x4*)(gk2 + (size_t)e * 64); st2 = *(const u32x4*)(gv0 + e); st3 = *(const u32x4*)(gv1 + e); }
        bf16x8 fa[8], fb[8];
#pragma unroll
        for (int ks = 0; ks < 4; ++ks) { const int co = ((2 * ks) << 4) ^ kx; fa[2 * ks] = *(const LAS bf16x8*)(buf + koff + co); fa[2 * ks + 1] = *(const LAS bf16x8*)(buf + koff + 4096 + co); }
        __builtin_amdgcn_sched_barrier(0);
        f32x16 S0 = (f32x16)(0.f), S1 = (f32x16)(0.f);
#pragma unroll
        for (int ks = 0; ks < 4; ++ks) { S0 = __builtin_amdgcn_mfma_f32_32x32x16_bf16(fa[2 * ks], qf[ks], S0, 0, 0, 0); S1 = __builtin_amdgcn_mfma_f32_32x32x16_bf16(fa[2 * ks + 1], qf[ks], S1, 0, 0, 0); }
#pragma unroll
        for (int kk = 0; kk < 2; ++kk) { const int co = ((2 * kk) << 4) ^ vx;
#pragma unroll
            for (int d = 0; d < 4; ++d) fb[kk * 4 + d] = *(const LAS bf16x8*)(buf + voff + d * 4096 + co); }
        __builtin_amdgcn_sched_barrier(0);
        float mx; { float m0 = max3f(S0[0], S0[1], S0[2]), m1 = max3f(S0[3], S0[4], S0[5]), m2 = max3f(S0[6], S0[7], S0[8]), m3 = max3f(S0[9], S0[10], S0[11]);
            float m4 = max3f(S0[12], S0[13], S0[14]), m5 = max3f(S0[15], S1[0], S1[1]), m6 = max3f(S1[2], S1[3], S1[4]), m7 = max3f(S1[5], S1[6], S1[7]);
            float m8 = max3f(S1[8], S1[9], S1[10]), m9 = max3f(S1[11], S1[12], S1[13]), m10 = max3f(S1[14], S1[15], m0);
            m1 = max3f(m1, m2, m3); m4 = max3f(m4, m5, m6); m7 = max3f(m7, m8, m9); mx = max3f(m1, m4, m7); mx = max3f(mx, m10, m10); }
        { const u32x2 sw2 = __builtin_amdgcn_permlane32_swap(__float_as_uint(mx), __float_as_uint(mx), false, false); mx = max3f(__uint_as_float(sw2.x), __uint_as_float(sw2.y), mx); }
        if (__builtin_amdgcn_ballot_w64(mx > mrun + TLAZY) != 0ull) {
            const float mnew = (mx > mrun + TLAZY) ? mx : mrun; const float alpha = __builtin_amdgcn_exp2f((mrun - mnew) * C);
            mrun = mnew; lsum *= alpha;
#pragma unroll
            for (int d = 0; d < 4; ++d) O[d] = O[d] * alpha; }
        { const float mc = mrun * C; S0 = S0 * C - mc; S1 = S1 * C - mc; }
#pragma unroll
        for (int i = 0; i < 16; ++i) { S0[i] = __builtin_amdgcn_exp2f(S0[i]); S1[i] = __builtin_amdgcn_exp2f(S1[i]); }
        { const f32x16 sv = S0 + S1;
          lsum += ((sv[0] + sv[1]) + (sv[2] + sv[3])) + ((sv[4] + sv[5]) + (sv[6] + sv[7])) + (((sv[8] + sv[9]) + (sv[10] + sv[11])) + ((sv[12] + sv[13]) + (sv[14] + sv[15]))); }
        bf16x8 pf[4];
#pragma unroll
        for (int s2 = 0; s2 < 2; ++s2) { u32x4 w0, w1;
            w0.x = pk2(S0[8 * s2 + 0], S0[8 * s2 + 1]); w0.y = pk2(S0[8 * s2 + 2], S0[8 * s2 + 3]); w0.z = pk2(S0[8 * s2 + 4], S0[8 * s2 + 5]); w0.w = pk2(S0[8 * s2 + 6], S0[8 * s2 + 7]);
            w1.x = pk2(S1[8 * s2 + 0], S1[8 * s2 + 1]); w1.y = pk2(S1[8 * s2 + 2], S1[8 * s2 + 3]); w1.z = pk2(S1[8 * s2 + 4], S1[8 * s2 + 5]); w1.w = pk2(S1[8 * s2 + 6], S1[8 * s2 + 7]);
            pf[s2] = __builtin_bit_cast(bf16x8, w0); pf[2 + s2] = __builtin_bit_cast(bf16x8, w1); }
        __builtin_amdgcn_sched_barrier(0);
#pragma unroll
        for (int kk = 2; kk < 4; ++kk) { const int co = ((2 * kk) << 4) ^ vx;
#pragma unroll
            for (int d = 0; d < 4; ++d) fa[(kk - 2) * 4 + d] = *(const LAS bf16x8*)(buf + voff + d * 4096 + co); }
        __builtin_amdgcn_sched_barrier(0);
#pragma unroll
        for (int kk = 0; kk < 2; ++kk)
#pragma unroll
            for (int d = 0; d < 4; ++d) O[d] = __builtin_amdgcn_mfma_f32_32x32x16_bf16(fb[kk * 4 + d], pf[kk], O[d], 0, 0, 0);
#pragma unroll
        for (int kk = 2; kk < 4; ++kk)
#pragma unroll
            for (int d = 0; d < 4; ++d) O[d] = __builtin_amdgcn_mfma_f32_32x32x16_bf16(fa[(kk - 2) * 4 + d], pf[kk], O[d], 0, 0, 0);
        if (p1) { LAS unsigned char* nb = lds + (((t + 1) & 1) << 15);
            *(LAS u32x4*)(nb + so) = st0; *(LAS u32x4*)(nb + 8192 + so) = st1; *(LAS u32x4*)(nb + 16384 + so) = st2; *(LAS u32x4*)(nb + 24576 + so) = st3; }
        __syncthreads();
    }
    const float l = lsum + __shfl_xor(lsum, 32);
    LAS float* comb = (LAS float*)(lds + 65536 + qsub * 16384);
    if (map == 1) {
        const float f = lam / l;
#pragma unroll
        for (int d = 0; d < 4; ++d)
#pragma unroll
            for (int i = 0; i < 16; ++i) comb[(d * 16 + i) * 64 + lane] = O[d][i] * f;
    }
    __syncthreads();
    if (map == 0) {
        const float inv = 1.0f / l; float ss = 0.f;
#pragma unroll
        for (int d = 0; d < 4; ++d)
#pragma unroll
            for (int i = 0; i < 16; ++i) { const float o = fmaf(O[d][i], inv, -comb[(d * 16 + i) * 64 + lane]); O[d][i] = o; ss = fmaf(o, o, ss); }
        ss += __shfl_xor(ss, 32);
        const float rs = rsqrtf(ss * (1.0f / 128.0f) + 1e-6f) * 0.8f;
        int r2 = r; asm volatile("" : "+v"(r2));
        LAS unsigned char* ot = lds + (qsub * 32 + r2) * 272;
#pragma unroll
        for (int d = 0; d < 4; ++d)
#pragma unroll
            for (int q = 0; q < 4; ++q) {
                const int dv = 32 * d + 8 * q + 4 * h;
                const f32x4 gg = *(const f32x4*)(gout + dv);
                u32x2 o; o.x = pk2(O[d][4 * q] * rs * gg[0], O[d][4 * q + 1] * rs * gg[1]); o.y = pk2(O[d][4 * q + 2] * rs * gg[2], O[d][4 * q + 3] * rs * gg[3]);
                *(LAS u32x2*)(ot + dv * 2) = o;
                if (q & 1) asm volatile("" ::: "memory");
            }
    }
    __syncthreads();
    int t2 = tid; asm volatile("" : "+v"(t2));
#pragma unroll
    for (int i = 0; i < 4; ++i) { const int q = t2 + 512 * i, row = q >> 4, cc = q & 15;
        *(u32x4*)(mixp + (size_t)row * 1024 + cc * 8) = *(const LAS u32x4*)(lds + row * 272 + cc * 16); }
    __syncthreads();
}

__device__ __forceinline__ void attn_phase(KP P, LAS unsigned char* lds, int tid, int lane, int wave, bool shadow = false, int tmul = 1) {
    unsigned char* ws = P->ws;
    const float d1 = wave_sum(P->in[13][lane] * P->in[14][lane]), d2 = wave_sum(P->in[15][lane] * P->in[16][lane]);
    const float lam = __expf(d1) - __expf(d2) + 0.2f;
    bf16* MIX = shadow ? (bf16*)(ws + 206 * MiB) : (bf16*)(ws + WS_XM);
    const float* aog = P->in[17];
    const int G = gridDim.x, bx = blockIdx.x;
    const int n_items = (G == 256) ? (bx >= 192 ? 6 : 2) : 0;
    for (int it = 0, j = bx; (G == 256) ? (it < n_items) : (j < 768); ++it, j += G) {
        int jj = j;
        if (G == 256) jj = it < 2 ? bx + 256 * it : 512 + (bx - 192) * 4 + (it - 2);
        if (jj < 512) {
            const int x = jj & 7, idx = jj >> 3, grp = x * 4 + (idx >> 4), qb = idx & 15, b = grp >> 2, hh = grp & 3;
            attn_unit(lds, (const bf16*)(ws + WS_QS) + (size_t)(b * 4 + hh) * 2 * 2048 * 64, 2048, qb * 128,
                      (const bf16*)(ws + WS_KS) + (size_t)(b * 4 + hh) * 2 * 2560 * 64, (const bf16*)(ws + WS_VTS) + ((size_t)b * 512 + hh * 128) * 2560, 2560,
                      MIX + ((size_t)NPROMPT + b * 2048 + qb * 128) * 1024 + hh * 128, aog + hh * 128, lam, tid, lane, wave, tmul);
        } else {
            const int k = jj - 512, grp = k >> 1, qb = k & 1, b = grp >> 2, hh = grp & 3;
            attn_unit(lds, (const bf16*)(ws + WS_QP) + (size_t)(b * 4 + hh) * 2 * 256 * 64, 256, qb * 128,
                      (const bf16*)(ws + WS_KP) + (size_t)(b * 4 + hh) * 2 * 256 * 64, (const bf16*)(ws + WS_VTP) + ((size_t)b * 512 + hh * 128) * 256, 256,
                      MIX + ((size_t)b * 256 + qb * 128) * 1024 + hh * 128, aog + hh * 128, lam, tid, lane, wave, tmul);
        }
    }
}

#define RLX_AGENT __ATOMIC_RELAXED, __HIP_MEMORY_SCOPE_AGENT
#define XB_TMO      128
#define XB_XCNT(j)  (256  + 64 * (j))
#define XB_XSUB(j)  (1280 + 64 * (j))
#define XB_XGEN(j)  (2304 + 64 * (j))
#define XB_TOP      3328
#define XB_TOPGEN   3392
#define XCD_BAR_WORDS 3456
#define XB_SPIN_CAP (1u << 18)

__device__ __forceinline__ unsigned xb_ld(unsigned* p)              { return __hip_atomic_load(p, __ATOMIC_RELAXED, __HIP_MEMORY_SCOPE_AGENT); }
__device__ __forceinline__ unsigned xb_add(unsigned* p, unsigned v) { return __hip_atomic_fetch_add(p, v, __ATOMIC_RELAXED, __HIP_MEMORY_SCOPE_AGENT); }
__device__ __forceinline__ unsigned xb_xcc_id() { return (unsigned)__builtin_amdgcn_s_getreg((3 << 11) | 20) & 0xFu; }
#define XB_SPIN(cond, bar) do { unsigned _sp = 0; while (cond) { __builtin_amdgcn_s_sleep(1); \
    if ((++_sp & 255u) == 0u) { if (xb_ld(&(bar)[XB_TMO])) break; if (_sp > XB_SPIN_CAP) { atomicAdd(&(bar)[XB_TMO], 1u); break; } } } } while (0)

struct XcdBarrier {
    unsigned* bar; unsigned x;
    volatile LAS unsigned* st;
};

__device__ __forceinline__ XcdBarrier xcd_barrier_post(unsigned* bar, volatile LAS unsigned* st) {
    XcdBarrier b; b.bar = bar; b.x = xb_xcc_id(); b.st = st;
    if (threadIdx.x == 0) (void)xb_add(&bar[XB_XCNT(b.x)], 1u);
    return b;
}
__device__ __forceinline__ void xcd_barrier_complete(unsigned* bar, unsigned x, unsigned& nloc, unsigned& nx) {
    const unsigned G = gridDim.x * gridDim.y * gridDim.z;
    unsigned sum, cnt, mine, sp = 0u;
    for (;;) {
        sum = 0u; cnt = 0u; mine = 0u;
#pragma unroll
        for (unsigned j = 0; j < 16; ++j) { const unsigned c = xb_ld(&bar[XB_XCNT(j)]); sum += c; cnt += (c > 0u) ? 1u : 0u; mine = (j == x) ? c : mine; }
        if (sum == G) break;
        __builtin_amdgcn_s_sleep(1);
        if ((++sp & 255u) == 0u) { if (xb_ld(&bar[XB_TMO])) break; if (sp > XB_SPIN_CAP) { atomicAdd(&bar[XB_TMO], 1u); break; } }
    }
    nloc = mine > 0u ? mine : 1u; nx = cnt > 0u ? cnt : 1u;
}

__device__ __forceinline__ void xcd_barrier(const XcdBarrier& b) {
    asm volatile("s_waitcnt vmcnt(0)" ::: "memory");
    __syncthreads();
    if (threadIdx.x == 0) {
        unsigned* bar = b.bar;
        __builtin_amdgcn_s_waitcnt(0);
        unsigned nloc = b.st[0], nx = b.st[1];
        if (nloc == 0u) { xcd_barrier_complete(bar, b.x, nloc, nx); b.st[0] = nloc; b.st[1] = nx; }
        const unsigned old = xb_add(&bar[XB_XSUB(b.x)], 1u);
        const unsigned gen = old / nloc;
        if (old + 1u == (gen + 1u) * nloc) {
            __builtin_amdgcn_fence(__ATOMIC_RELEASE, "agent");
            asm volatile("s_waitcnt vmcnt(0)" ::: "memory");
            const unsigned og = xb_add(&bar[XB_TOP], 1u);
            const unsigned tg = og / nx;
            if (og + 1u == (tg + 1u) * nx) xb_add(&bar[XB_TOPGEN], 1u);
            else XB_SPIN(xb_ld(&bar[XB_TOPGEN]) == tg, bar);
            __builtin_amdgcn_fence(__ATOMIC_ACQUIRE, "agent");
            xb_add(&bar[XB_XGEN(b.x)], 1u);
            asm volatile("s_waitcnt vmcnt(0)" ::: "memory");
        } else {
            XB_SPIN(xb_ld(&bar[XB_XGEN(b.x)]) == gen, bar);
            __builtin_amdgcn_fence(__ATOMIC_ACQUIRE, "agent");
            asm volatile("s_waitcnt vmcnt(0)" ::: "memory");
        }
    }
    __syncthreads();
}

__global__ void __launch_bounds__(512, 2) fwd_megakernel(Params Parg) {
    extern __shared__ __attribute__((aligned(16))) unsigned char lds_raw[];
    LAS unsigned char* lds = (LAS unsigned char*)lds_raw;
    const int tid = threadIdx.x, lane = tid & 63, wave = __builtin_amdgcn_readfirstlane(tid >> 6);
    int lo, hi; XcdBarrier xbar;
    { KP P = kargs(); lo = P->ph_lo; hi = P->ph_hi;
      volatile LAS unsigned* bst = (volatile LAS unsigned*)(lds + 147456);
      if (tid == 0) { bst[0] = 0u; bst[1] = 0u; }
      __syncthreads();
      xbar = xcd_barrier_post((unsigned*)(P->ws + WS_BAR), bst); }
#define IN(k) (lo <= (k) && (k) < hi)
#define SEAM(k) do { if (IN(k) && IN((k) + 1)) { xcd_barrier(xbar); } } while (0)
    if (hi > NPHASE + 1) cg::this_grid().sync();
    if (IN(0)) { KP P = kargs(); p0_ada(P, lds, tid, lane, wave); }
    SEAM(0);
    const bool defer = gridDim.x == 256;
    if (IN(1)) { KP P = kargs(); convert_job(P, lds, tid, lane, wave, defer ? 2 : 31, (int)blockIdx.x, (int)gridDim.x); }
    if (IN(1)) { KP P = kargs(); unsigned char* ws = P->ws; norm_phase(P->in[0], P->in[1], P->in[6], (const float*)(ws + WS_MODS), 0, 1024, (bf16*)(ws + WS_XM), lane, wave); }
    SEAM(1);
    if (IN(2)) {
        KP P = kargs(); unsigned char* ws = P->ws;
        pg8::Gemm g{(const bf16*)(ws + WS_XM), (const bf16*)(ws + WS_W1T), NTOK, NIN, 1024}; pg8::StaticOrder S; S.init(NTOK, NIN, (int)gridDim.x, (int)blockIdx.x);
        pg8::EpiIn E{ws, P->out, P->in[11], P->in[12]};
        pg8::gemm_phase<pg8::EpiIn, pg8::StaticOrder, true, true>(lds, g, S, E);
    }
    if (IN(2) && defer && blockIdx.x >= 192) { KP P = kargs(); convert_job(P, lds, tid, lane, wave, 1 | 4, (int)blockIdx.x - 192, 64); }
    SEAM(2);
    if (IN(3)) { KP P = kargs(); sgu_phase(P, lds, tid, lane, wave); attn_phase(P, lds, tid, lane, wave); }
    SEAM(3);
    if (IN(4)) {
        KP P = kargs(); unsigned char* ws = P->ws;
        pg8::Gemm g{(const bf16*)(ws + WS_XM), (const bf16*)(ws + WS_W2T), NTOK, 1024, 1024}; pg8::StaticOrder S; S.init(NTOK, 1024, (int)gridDim.x, (int)blockIdx.x);
        pg8::EpiRes E{P->in[0], P->in[1], P->out + OUT_Y, (const float*)(ws + WS_MODS) + 2048, false};
        pg8::gemm_phase<pg8::EpiRes, pg8::StaticOrder, true, true>(lds, g, S, E);
    }
    if (IN(4) && defer && blockIdx.x >= 128) { KP P = kargs(); convert_job(P, lds, tid, lane, wave, 8 | 16, (int)blockIdx.x - 128, 128); }
    SEAM(4);
    if (IN(5)) { KP P = kargs(); unsigned char* ws = P->ws; float* out = P->out; norm_phase(out + OUT_Y, out + OUT_Y + (size_t)NPROMPT * DM, P->in[7], (const float*)(ws + WS_MODS), 3072, 4096, (bf16*)(ws + WS_XM), lane, wave); }
    SEAM(5);
    if (IN(6)) {
        KP P = kargs(); unsigned char* ws = P->ws;
        pg8::Gemm g{(const bf16*)(ws + WS_XM), (const bf16*)(ws + WS_W3T), NTOK, 2 * DFF, 1024}; pg8::StaticOrder S; S.init(NTOK, 2 * DFF, (int)gridDim.x, (int)blockIdx.x);
        pg8::EpiSwiglu E{(bf16*)(ws + WS_HID)};
        pg8::gemm_phase<pg8::EpiSwiglu, pg8::StaticOrder, true, true>(lds, g, S, E);
    }
    SEAM(6);
    if (IN(7)) {
        KP P = kargs(); unsigned char* ws = P->ws; float* out = P->out;
        pg8::Gemm g{(const bf16*)(ws + WS_HID), (const bf16*)(ws + WS_W4T), NTOK, 1024, DFF}; pg8::StaticOrder S; S.init(NTOK, 1024, (int)gridDim.x, (int)blockIdx.x);
        pg8::EpiRes E{out + OUT_Y, out + OUT_Y + (size_t)NPROMPT * DM, out + OUT_Y, (const float*)(ws + WS_MODS) + 5120, true};
        pg8::gemm_phase<pg8::EpiRes, pg8::StaticOrder, true, true>(lds, g, S, E);
    }
#undef IN
#undef SEAM
}

extern "C" void kernel_launch(void* const* d_in, const int* in_sizes, int n_in, void* d_out, int out_size, void* d_ws, size_t ws_size, hipStream_t stream) {
    static int grid = 0;
    if (grid == 0) {
        if (n_in != 25 || ws_size < WS_END) { fprintf(stderr, "kernel_launch: built for 25 inputs and >= %zu bytes of workspace; got %d, %zu\n", (size_t)WS_END, n_in, ws_size); grid = -1; return; }
        int dev = 0, cus = 0, per_cu = 0;
        if (hipGetDevice(&dev) != hipSuccess || hipDeviceGetAttribute(&cus, hipDeviceAttributeMultiprocessorCount, dev) != hipSuccess) { grid = -1; return; }
        if (hipFuncSetAttribute((const void*)fwd_megakernel, hipFuncAttributeMaxDynamicSharedMemorySize, LDS_BYTES) != hipSuccess) { fprintf(stderr, "kernel_launch: hipFuncSetAttribute failed\n"); grid = -1; return; }
        if (hipOccupancyMaxActiveBlocksPerMultiprocessor(&per_cu, (const void*)fwd_megakernel, 512, LDS_BYTES) != hipSuccess || per_cu < 1) { fprintf(stderr, "kernel_launch: occupancy query says %d\n", per_cu); per_cu = 1; }
        (void)hipGetLastError();
        grid = cus * per_cu;
    }
    if (grid < 0) return;
    if (hipMemsetAsync((char*)d_ws + WS_BAR, 0, XCD_BAR_WORDS * 4, stream) != hipSuccess) { fprintf(stderr, "kernel_launch: hipMemsetAsync failed\n"); return; }
    Params p{};
    for (int i = 0; i < 25; ++i) p.in[i] = (const float*)d_in[i];
    p.out = (float*)d_out; p.ws = (unsigned char*)d_ws;
#if MK_N_LAUNCHES == 1
    p.ph_lo = 0; p.ph_hi = NPHASE;
    void* args[] = {&p};
    hipError_t e = hipLaunchCooperativeKernel((const void*)fwd_megakernel, dim3(grid), dim3(512), args, LDS_BYTES, stream);
    if (e != hipSuccess) fprintf(stderr, "kernel_launch: cooperative launch failed: %s (grid %d)\n", hipGetErrorString(e), grid);
#else
    for (int k = 0; k < NPHASE; ++k) {
        p.ph_lo = k; p.ph_hi = k + 1;
        hipLaunchKernelGGL(fwd_megakernel, dim3(grid), dim3(512), LDS_BYTES, stream, p);
    }
#endif
}
```

```cpp
#include <hip/hip_runtime.h>
#include <hip/hip_cooperative_groups.h>
#include <cstdio>
#include <cstdint>
namespace cg = cooperative_groups;

#ifndef MK_N_LAUNCHES
#define MK_N_LAUNCHES 1
#endif

typedef unsigned short bf16;
constexpr int NTOK = 24576, NPROMPT = 8192, DM = 1024, DFF = 2816, NIN = 2560;
constexpr size_t MiB = 1u << 20;
constexpr size_t WS_MODS = 0, WS_ROPEC = 256 * 1024, WS_ROPES = 260 * 1024, WS_SSQ = 512 * 1024;
constexpr size_t WS_W1T = 1 * MiB, WS_W2T = 6 * MiB, WS_W3T = 8 * MiB, WS_W4T = 19 * MiB;
constexpr size_t WS_XM = 25 * MiB;
constexpr size_t WS_A = 73 * MiB;
constexpr size_t WS_QP = WS_A, WS_QS = WS_A + 8 * MiB, WS_KP = WS_A + 24 * MiB, WS_KS = WS_A + 32 * MiB;
constexpr size_t WS_VTP = WS_A + 52 * MiB, WS_VTS = WS_A + 60 * MiB, WS_U = WS_A + 80 * MiB, WS_GVTP = WS_A + 104 * MiB, WS_GVTS = WS_A + 112 * MiB;
constexpr size_t WS_HID = WS_A, WS_X1B = 206 * MiB, WS_END = 254 * MiB;
static_assert(WS_GVTS + 16 * MiB <= WS_END && WS_END <= 256 * MiB, "workspace map");
constexpr size_t OUT_Y = 0, OUT_STK = (size_t)NTOK * DM, OUT_STV = OUT_STK + 4194304;

namespace pg8 {
#define PG8_LAS __attribute__((address_space(3)))
typedef unsigned short bf16_t;
typedef short bf16x8 __attribute__((ext_vector_type(8)));
typedef float f32x4 __attribute__((ext_vector_type(4)));
typedef unsigned u32x4 __attribute__((ext_vector_type(4)));
constexpr int BM = 256, BK = 64, HALF = 128, HTB = HALF * BK * 2  , STAGE_BYTES = 8 * HTB, NXCD = 8, WGM = 8;

__host__ __device__ __forceinline__ int lds_byte(int r, int c) { const int st = (r >> 4) * 2 + (c >> 5), rr = r & 15, cc = c & 31, ob = rr * 64 + cc * 2; return st * 1024 + (ob ^ (((ob >> 9) & 1) << 5)); }
__host__ __device__ __forceinline__ void stage_rc(int b, int& R, int& C) { const int st = b / 1024, sb = b % 1024, swz = sb ^ (((sb >> 9) & 1) << 5); R = (st >> 1) * 16 + swz / 64; C = (st & 1) * 32 + (swz % 64) / 2; }
__host__ __device__ __forceinline__ int perm32(int rho) { const int n = rho >> 4, i = rho & 15; return 8 * (i >> 2) + 4 * n + (i & 3); }

struct Unit { int pm, pn; };
struct Gemm { const bf16_t* A; const bf16_t* Bt; int M, N, K; };

struct StaticOrder {
    int nM, nN, nwg, G, c;
    __host__ __device__ void init(int M, int N, int G_, int c_) { nM = M / BM; nN = N / BM; nwg = nM * nN; G = G_; c = c_; }
    __host__ __device__ bool next(int i, Unit& u) const {
        const long L = (long)i * G + c; if (L >= nwg) return false;
        int wgid = (int)L; { const int q = nwg / NXCD, r = nwg % NXCD, xcd = wgid % NXCD, off = wgid / NXCD; wgid = (xcd < r ? xcd * (q + 1) : r * (q + 1) + (xcd - r) * q) + off; }
        const int nig = WGM * nN, gid = wgid / nig, fm = gid * WGM, gsz = (nM - fm) < WGM ? (nM - fm) : WGM;
        u.pm = fm + ((wgid % nig) % gsz); u.pn = (wgid % nig) / gsz; return true;
    }
    __device__ __forceinline__ void a_ready(const Unit&) const {}
    __device__ __forceinline__ void done(const Unit&) const {}
};

__device__ __forceinline__ unsigned cvt_pk_bf16(float lo, float hi) { unsigned r; asm volatile("v_cvt_pk_bf16_f32 %0, %1, %2" : "=v"(r) : "v"(lo), "v"(hi)); return r; }
typedef float f32x2 __attribute__((ext_vector_type(2)));
typedef unsigned u32x2 __attribute__((ext_vector_type(2)));
__device__ __forceinline__ u32x2 pack4(const f32x4 v) { u32x2 w; w.x = cvt_pk_bf16(v[0], v[1]); w.y = cvt_pk_bf16(v[2], v[3]); return w; }
__device__ __forceinline__ bf16_t bf1(float v) { return (bf16_t)(cvt_pk_bf16(v, 0.f) & 0xffffu); }

struct EpiIn {
    static constexpr bool PERM = false, AFTER_DRAIN = false;
    unsigned char* ws; float* out; const float *qg, *kg;
    __device__ __forceinline__ void operator()(const f32x4 (&acc)[2][2][4][2], const Unit& u, int wr, int wc, int fr, int fq) const {
        asm volatile("" : "+v"(fr), "+v"(fq));
        const int pm = u.pm, pn = u.pn;
        const bool prompt = pm < 32;
        const int b = prompt ? pm : ((pm - 32) >> 3);
        const int s0 = prompt ? 0 : (((pm - 32) & 7) << 8);
        const int kind = pn >> 1;
        const int chw = ((pn & 1) << 8) + (wc << 6);
        if (kind <= 1) {
            const int hm = chw >> 6;
            const float* gain = kind == 0 ? qg : kg;
            f32x4 g4[2][2];
#pragma unroll
            for (int bj = 0; bj < 2; ++bj)
#pragma unroll
                for (int n = 0; n < 2; ++n) g4[bj][n] = *(const f32x4*)(gain + 32 * bj + 16 * n + 4 * fq);
            const int Sx = prompt ? 256 : (kind == 0 ? 2048 : 2560);
            bf16_t* dst = (bf16_t*)(ws + (kind == 0 ? (prompt ? WS_QP : WS_QS) : (prompt ? WS_KP : WS_KS))) + ((size_t)(b * 8 + hm) * Sx + s0) * 64 + 4 * fq;
            float* dstK = out + OUT_STK + ((size_t)(b * 8 + hm) * 256) * 64 + 4 * fq;
#pragma unroll
            for (int ai = 0; ai < 2; ++ai)
#pragma unroll
                for (int m = 0; m < 4; ++m) {
                    const int rl = ai * 128 + wr * 64 + m * 16 + fr;
                    f32x4 v[2][2]; float ss = 0.f;
#pragma unroll
                    for (int bj = 0; bj < 2; ++bj)
#pragma unroll
                        for (int n = 0; n < 2; ++n) { v[bj][n] = acc[ai][bj][m][n]; const f32x4 q = v[bj][n] * v[bj][n]; ss += (q[0] + q[1]) + (q[2] + q[3]); }
                    ss += __shfl_xor(ss, 16); ss += __shfl_xor(ss, 32);
                    const float rstd = rsqrtf(ss * (1.0f / 64.0f) + 1e-6f);
#pragma unroll
                    for (int bj = 0; bj < 2; ++bj)
#pragma unroll
                        for (int n = 0; n < 2; ++n) v[bj][n] = v[bj][n] * rstd * g4[bj][n];
                    if (!prompt) {
                        const int gr = (s0 >> 6) + 2 * ai + wr, gc = 16 * m + fr;
#pragma unroll
                        for (int bj = 0; bj < 2; ++bj) {
                            const int pos = bj == 0 ? gr : gc;
                            const f32x4 c4 = *(const f32x4*)((const float*)(ws + WS_ROPEC) + pos * 16 + 4 * fq), s4 = *(const f32x4*)((const float*)(ws + WS_ROPES) + pos * 16 + 4 * fq);
                            const f32x4 a1 = v[bj][0], a2 = v[bj][1];
                            v[bj][0] = a1 * c4 - a2 * s4; v[bj][1] = a2 * c4 + a1 * s4;
                        }
                    }
#pragma unroll
                    for (int bj = 0; bj < 2; ++bj)
#pragma unroll
                        for (int n = 0; n < 2; ++n) *(u32x2*)(dst + (size_t)rl * 64 + 32 * bj + 16 * n) = pack4(v[bj][n]);
                    if (prompt && kind == 1) {
#pragma unroll
                        for (int bj = 0; bj < 2; ++bj)
#pragma unroll
                            for (int n = 0; n < 2; ++n) __builtin_nontemporal_store(v[bj][n], (f32x4*)(dstK + (size_t)rl * 64 + 32 * bj + 16 * n));
                    }
                    asm volatile("" ::: "memory");
                }
        } else if (kind == 3) {
            bf16_t* dst = (bf16_t*)(ws + WS_U) + (size_t)(pm * 256) * 512 + chw + 4 * fq;
#pragma unroll
            for (int ai = 0; ai < 2; ++ai)
#pragma unroll
                for (int m = 0; m < 4; ++m) {
                    const int rl = ai * 128 + wr * 64 + m * 16 + fr;
#pragma unroll
                    for (int bj = 0; bj < 2; ++bj)
#pragma unroll
                        for (int n = 0; n < 2; ++n) *(u32x2*)(dst + (size_t)rl * 512 + 32 * bj + 16 * n) = pack4(acc[ai][bj][m][n]);
                    asm volatile("" ::: "memory");
                }
        } else {
            const int Sx = prompt ? 256 : (kind == 2 ? 2560 : 2048);
            bf16_t* dst = (bf16_t*)(ws + (kind == 2 ? (prompt ? WS_VTP : WS_VTS) : (prompt ? WS_GVTP : WS_GVTS))) + ((size_t)b * 512 + chw) * Sx + s0;
            float* dstV = out + OUT_STV + ((size_t)(b * 4 + (chw >> 7)) * 256) * 128 + (chw & 127);
            float* dq = (float*)(ws + WS_SSQ) + (size_t)(pm * 256) * 4 + (chw >> 7);
            const unsigned lo = (unsigned)(4 * fq) * (unsigned)Sx + (unsigned)(wr * 64 + fr);
#pragma unroll
            for (int ai = 0; ai < 2; ++ai)
#pragma unroll
                for (int m = 0; m < 4; ++m) {
                    const int rl = ai * 128 + wr * 64 + m * 16 + fr;
                    float ss = 0.f;
#pragma unroll
                    for (int bj = 0; bj < 2; ++bj)
#pragma unroll
                        for (int n = 0; n < 2; ++n) {
                            const f32x4 v = acc[ai][bj][m][n]; const int co = 32 * bj + 16 * n;
                            bf16_t* dc = dst + (size_t)co * Sx + (ai * 128 + m * 16);
#pragma unroll
                            for (int j = 0; j < 4; ++j) dc[lo + (unsigned)j * (unsigned)Sx] = bf1(v[j]);
                            if (kind == 2 && prompt) __builtin_nontemporal_store(v, (f32x4*)(dstV + (size_t)rl * 128 + co + 4 * fq));
                            const f32x4 q = v * v; ss += (q[0] + q[1]) + (q[2] + q[3]);
                        }
                    if (kind == 4) {
                        ss += __shfl_xor(ss, 16); ss += __shfl_xor(ss, 32);
                        if (fq == 0) atomicAdd(dq + (size_t)rl * 4, ss);
                    }
                    asm volatile("" ::: "memory");
                }
        }
    }
};

struct EpiRes1 {
    static constexpr bool PERM = false, AFTER_DRAIN = false;
    const float *base_p, *base_s; bf16_t* out; const float* gate;
    __device__ __forceinline__ void operator()(const f32x4 (&acc)[2][2][4][2], const Unit& u, int wr, int wc, int fr, int fq) const {
        asm volatile("" : "+v"(fr), "+v"(fq));
        const int pm = u.pm, cond = pm < 32 ? 0 : 1 + ((pm - 32) >> 3);
        const float* base = pm < 32 ? base_p + (size_t)pm * 256 * 1024 : base_s + (size_t)(pm - 32) * 256 * 1024;
        bf16_t* o = out + (size_t)pm * 256 * 1024;
        const int col0 = u.pn * 256 + wc * 32 + 4 * fq;
        f32x4 gv[2][2];
#pragma unroll
        for (int bj = 0; bj < 2; ++bj)
#pragma unroll
            for (int n = 0; n < 2; ++n) gv[bj][n] = *(const f32x4*)(gate + cond * 6144 + col0 + bj * 128 + n * 16);
#pragma unroll
        for (int ai = 0; ai < 2; ++ai) {
            f32x4 bs[4][2][2];
#pragma unroll
            for (int m = 0; m < 4; ++m) { const size_t ro = (size_t)(ai * 128 + wr * 64 + m * 16 + fr) * 1024 + col0;
#pragma unroll
                for (int bj = 0; bj < 2; ++bj)
#pragma unroll
                    for (int n = 0; n < 2; ++n) bs[m][bj][n] = __builtin_nontemporal_load((const f32x4*)(base + ro + bj * 128 + n * 16)); }
            asm volatile("" ::: "memory");
#pragma unroll
            for (int m = 0; m < 4; ++m) { const size_t ro = (size_t)(ai * 128 + wr * 64 + m * 16 + fr) * 1024 + col0;
#pragma unroll
                for (int bj = 0; bj < 2; ++bj)
#pragma unroll
                    for (int n = 0; n < 2; ++n) *(u32x2*)(o + ro + bj * 128 + n * 16) = pack4(bs[m][bj][n] + gv[bj][n] * acc[ai][bj][m][n]); }
            asm volatile("" ::: "memory");
        }
    }
};
struct EpiRes2 {
    static constexpr bool PERM = false, AFTER_DRAIN = false;
    const bf16_t* base; float* out; const float* gate;
    __device__ __forceinline__ void operator()(const f32x4 (&acc)[2][2][4][2], const Unit& u, int wr, int wc, int fr, int fq) const {
        asm volatile("" : "+v"(fr), "+v"(fq));
        const int pm = u.pm, cond = pm < 32 ? 0 : 1 + ((pm - 32) >> 3);
        const bf16_t* b = base + (size_t)pm * 256 * 1024;
        float* o = out + (size_t)pm * 256 * 1024;
        const int col0 = u.pn * 256 + wc * 32 + 4 * fq;
        f32x4 gv[2][2];
#pragma unroll
        for (int bj = 0; bj < 2; ++bj)
#pragma unroll
            for (int n = 0; n < 2; ++n) gv[bj][n] = *(const f32x4*)(gate + cond * 6144 + col0 + bj * 128 + n * 16);
#pragma unroll
        for (int ai = 0; ai < 2; ++ai) {
            u32x2 bs[4][2][2];
#pragma unroll
            for (int m = 0; m < 4; ++m) { const size_t ro = (size_t)(ai * 128 + wr * 64 + m * 16 + fr) * 1024 + col0;
#pragma unroll
                for (int bj = 0; bj < 2; ++bj)
#pragma unroll
                    for (int n = 0; n < 2; ++n) bs[m][bj][n] = __builtin_nontemporal_load((const u32x2*)(b + ro + bj * 128 + n * 16)); }
            asm volatile("" ::: "memory");
#pragma unroll
            for (int m = 0; m < 4; ++m) { const size_t ro = (size_t)(ai * 128 + wr * 64 + m * 16 + fr) * 1024 + col0;
#pragma unroll
                for (int bj = 0; bj < 2; ++bj)
#pragma unroll
                    for (int n = 0; n < 2; ++n) { const u32x2 w = bs[m][bj][n];
                        const f32x4 x1 = (f32x4){__uint_as_float(w.x << 16), __uint_as_float(w.x & 0xffff0000u), __uint_as_float(w.y << 16), __uint_as_float(w.y & 0xffff0000u)};
                        __builtin_nontemporal_store(x1 + gv[bj][n] * acc[ai][bj][m][n], (f32x4*)(o + ro + bj * 128 + n * 16)); } }
            asm volatile("" ::: "memory");
        }
    }
};

struct EpiSwiglu {
    static constexpr bool PERM = false, AFTER_DRAIN = false;
    bf16_t* H;
    __device__ __forceinline__ void operator()(const f32x4 (&acc)[2][2][4][2], const Unit& u, int wr, int wc, int fr, int fq) const {
        asm volatile("" : "+v"(fr), "+v"(fq));
        bf16_t* dst = H + (size_t)(u.pm * 256) * 2816 + u.pn * 128 + wc * 32 + 4 * fq;
#pragma unroll
        for (int ai = 0; ai < 2; ++ai)
#pragma unroll
            for (int m = 0; m < 4; ++m) {
                const int rl = ai * 128 + wr * 64 + m * 16 + fr;
#pragma unroll
                for (int n = 0; n < 2; ++n) {
                    const f32x4 g = acc[ai][0][m][n], up = acc[ai][1][m][n]; f32x4 h;
#pragma unroll
                    for (int j = 0; j < 4; ++j) h[j] = g[j] * __builtin_amdgcn_rcpf(1.0f + __expf(-g[j])) * up[j];
                    *(u32x2*)(dst + (size_t)rl * 2816 + 16 * n) = pack4(h);
                }
            }
    }
};

template <class Epi, class Sched, bool ALIGN_EPI = false, bool SP2 = false>
__device__ __forceinline__ void gemm_phase(PG8_LAS unsigned char* lds, const Gemm g, const Sched& S, const Epi& E) {
    const int tid = threadIdx.x, wid = __builtin_amdgcn_readfirstlane(tid >> 6), lane = tid & 63, wr = wid >> 2, wc = wid & 3, fr = lane & 15, fq = lane >> 4;
    const int K = g.K, nt = K / BK;
    unsigned voffA[2], voffB[2];
#pragma unroll
    for (int i = 0; i < 2; ++i) { int R, C; stage_rc(tid * 16 + i * 8192, R, C); const int Rb = Epi::PERM ? ((R & ~31) + perm32(R & 31)) : R;
        voffA[i] = (unsigned)(R * K + C) * 2u; voffB[i] = (unsigned)(Rb * K + C) * 2u; }
    const size_t kstep = (size_t)(BK * 2);
    const size_t hstep = (size_t)HALF * K * 2;
    const size_t tstep = 2 * hstep;
    const unsigned ldsw = (unsigned)wid * 1024u;
    const int aoff = lds_byte(wr * 64 + fr, fq * 8), boff = lds_byte(wc * 32 + fr, fq * 8);
#define PG8_SA(b, h) (((b) * 2 + (h)) * HTB)
#define PG8_SB(b, h) ((4 + (b) * 2 + (h)) * HTB)
#define PG8_STAGE(bufoff, gbase, voff) do { _Pragma("unroll") for (int _i = 0; _i < 2; ++_i) \
        __builtin_amdgcn_global_load_lds((const unsigned*)((const char*)(gbase) + (voff)[_i]), (PG8_LAS unsigned*)(lds + (bufoff) + ldsw + _i * 8192), 16, 0, 0); } while (0)
#define PG8_LDA(dst, b, h) do { _Pragma("unroll") for (int m = 0; m < 4; ++m) _Pragma("unroll") for (int k = 0; k < 2; ++k) dst[m][k] = *(const PG8_LAS bf16x8*)(lds + PG8_SA(b, h) + aoff + m * 2048 + k * 1024); } while (0)
#define PG8_LDB(dst, b, h) do { _Pragma("unroll") for (int n = 0; n < 2; ++n) _Pragma("unroll") for (int k = 0; k < 2; ++k) dst[n][k] = *(const PG8_LAS bf16x8*)(lds + PG8_SB(b, h) + boff + n * 2048 + k * 1024); } while (0)
#define PG8_MMA(ai, bj, At, Bt) do { __builtin_amdgcn_s_setprio(1); _Pragma("unroll") for (int m = 0; m < 4; ++m) _Pragma("unroll") for (int n = 0; n < 2; ++n) _Pragma("unroll") for (int k = 0; k < 2; ++k) \
        acc[ai][bj][m][n] = __builtin_amdgcn_mfma_f32_16x16x32_bf16(Bt[n][k], At[m][k], acc[ai][bj][m][n], 0, 0, 0); __builtin_amdgcn_s_setprio(0); } while (0)
#define PG8_WAIT_V(n) asm volatile("s_waitcnt vmcnt(" #n ")" ::: "memory")
#define PG8_WAIT_L(n) asm volatile("s_waitcnt lgkmcnt(" #n ")" ::: "memory")
#define PG8_BAR __builtin_amdgcn_s_barrier()
#define PG8_SCHED __builtin_amdgcn_sched_barrier(0)
    Unit cur, nxt; int ui = 0;
    if (!S.next(0, cur)) return;
    f32x4 acc[2][2][4][2];
#pragma unroll
    for (int a = 0; a < 2; ++a)
#pragma unroll
        for (int b = 0; b < 2; ++b)
#pragma unroll
            for (int m = 0; m < 4; ++m)
#pragma unroll
                for (int n = 0; n < 2; ++n) acc[a][b][m][n] = (f32x4){0.f, 0.f, 0.f, 0.f};
    bf16x8 At[4][2], B0[2][2], B1[2][2];
    const char* cA = (const char*)g.A + (size_t)cur.pm * tstep; const char* cB = (const char*)g.Bt + (size_t)cur.pn * tstep;
    S.a_ready(cur);
    if constexpr (SP2) {
        PG8_STAGE(PG8_SB(0, 0), cB, voffB); PG8_STAGE(PG8_SB(0, 1), cB + hstep, voffB); PG8_STAGE(PG8_SA(0, 0), cA, voffA); PG8_STAGE(PG8_SA(0, 1), cA + hstep, voffA);
        if (wr == 1) PG8_BAR;
        PG8_WAIT_V(2); PG8_BAR;
        PG8_STAGE(PG8_SB(1, 0), cB + kstep, voffB); PG8_STAGE(PG8_SA(1, 0), cA + kstep, voffA); PG8_STAGE(PG8_SB(1, 1), cB + hstep + kstep, voffB);
        PG8_WAIT_V(6); PG8_BAR;
    } else {
        PG8_STAGE(PG8_SB(0, 0), cB, voffB); PG8_STAGE(PG8_SA(0, 0), cA, voffA); PG8_STAGE(PG8_SB(0, 1), cB + hstep, voffB); PG8_STAGE(PG8_SA(0, 1), cA + hstep, voffA);
        if (wr == 1) PG8_BAR;
        PG8_WAIT_V(4); PG8_BAR;
        PG8_STAGE(PG8_SB(1, 0), cB + kstep, voffB); PG8_STAGE(PG8_SA(1, 0), cA + kstep, voffA); PG8_STAGE(PG8_SB(1, 1), cB + hstep + kstep, voffB);
        PG8_WAIT_V(6); PG8_BAR;
    }
    for (;;) {
        const bool has_next = S.next(ui + 1, nxt);
        const char* nA = has_next ? (const char*)g.A + (size_t)nxt.pm * tstep : cA; const char* nB = has_next ? (const char*)g.Bt + (size_t)nxt.pn * tstep : cB;
        for (int t = 0; t < nt; t += 2) {
            const bool last = (t == nt - 2);
            const char* a1 = cA + (size_t)(t + 1) * kstep;
            const char* a2 = last ? nA : cA + (size_t)(t + 2) * kstep; const char* b2 = last ? nB : cB + (size_t)(t + 2) * kstep;
            const char* a3 = a2 + kstep; const char* b3 = b2 + kstep;
            if (last && has_next) S.a_ready(nxt);
            if constexpr (SP2) {
            PG8_LDB(B0, 0, 0); PG8_LDB(B1, 0, 1); PG8_SCHED; PG8_LDA(At, 0, 0); PG8_STAGE(PG8_SA(1, 1), a1 + hstep, voffA);
            PG8_WAIT_V(8); PG8_WAIT_L(0); PG8_BAR; PG8_MMA(0, 0, At, B0); PG8_MMA(0, 1, At, B1); PG8_BAR; PG8_SCHED;
            PG8_LDA(At, 0, 1); PG8_STAGE(PG8_SB(0, 0), b2, voffB); PG8_STAGE(PG8_SB(0, 1), b2 + hstep, voffB); PG8_STAGE(PG8_SA(0, 0), a2, voffA);
            PG8_WAIT_V(8); PG8_WAIT_L(0); PG8_BAR; PG8_MMA(1, 0, At, B0); PG8_MMA(1, 1, At, B1); PG8_BAR; PG8_SCHED;
            PG8_LDB(B0, 1, 0); PG8_LDB(B1, 1, 1); PG8_SCHED; PG8_LDA(At, 1, 0); PG8_STAGE(PG8_SA(0, 1), a2 + hstep, voffA);
            PG8_WAIT_V(8); PG8_WAIT_L(0); PG8_BAR; PG8_MMA(0, 0, At, B0); PG8_MMA(0, 1, At, B1); PG8_BAR; PG8_SCHED;
            PG8_LDA(At, 1, 1); PG8_STAGE(PG8_SB(1, 0), b3, voffB); PG8_STAGE(PG8_SB(1, 1), b3 + hstep, voffB); PG8_STAGE(PG8_SA(1, 0), a3, voffA);
            PG8_WAIT_V(8); PG8_WAIT_L(0); PG8_BAR; PG8_MMA(1, 0, At, B0); PG8_MMA(1, 1, At, B1); PG8_BAR; PG8_SCHED;
            } else {
            PG8_LDB(B0, 0, 0); PG8_SCHED; PG8_LDA(At, 0, 0); PG8_STAGE(PG8_SA(1, 1), a1 + hstep, voffA);
            PG8_WAIT_L(8); PG8_BAR; PG8_WAIT_L(0); PG8_MMA(0, 0, At, B0); PG8_BAR; PG8_SCHED;
            PG8_LDB(B1, 0, 1); PG8_STAGE(PG8_SB(0, 0), b2, voffB);
            PG8_BAR; PG8_WAIT_L(0); PG8_MMA(0, 1, At, B1); PG8_BAR;
            PG8_LDA(At, 0, 1); PG8_STAGE(PG8_SA(0, 0), a2, voffA);
            PG8_BAR; PG8_WAIT_L(0); PG8_MMA(1, 0, At, B0); PG8_BAR; PG8_SCHED;
            PG8_STAGE(PG8_SB(0, 1), b2 + hstep, voffB);
            PG8_WAIT_V(6); PG8_BAR; PG8_MMA(1, 1, At, B1); PG8_BAR;
            PG8_LDB(B0, 1, 0); PG8_SCHED; PG8_LDA(At, 1, 0); PG8_STAGE(PG8_SA(0, 1), a2 + hstep, voffA);
            PG8_WAIT_L(8); PG8_BAR; PG8_WAIT_L(0); PG8_MMA(0, 0, At, B0); PG8_BAR; PG8_SCHED;
            PG8_LDB(B1, 1, 1); PG8_STAGE(PG8_SB(1, 0), b3, voffB);
            PG8_BAR; PG8_WAIT_L(0); PG8_MMA(0, 1, At, B1); PG8_BAR;
            PG8_LDA(At, 1, 1); PG8_STAGE(PG8_SA(1, 0), a3, voffA);
            PG8_BAR; PG8_WAIT_L(0); PG8_MMA(1, 0, At, B0); PG8_BAR; PG8_SCHED;
            PG8_STAGE(PG8_SB(1, 1), b3 + hstep, voffB);
            PG8_WAIT_V(6); PG8_BAR; PG8_MMA(1, 1, At, B1); PG8_BAR;
            }
        }
        if constexpr (ALIGN_EPI) { if (wr == 0) PG8_BAR; }
        if constexpr (!Epi::AFTER_DRAIN) { E(acc, cur, wr, wc, fr, fq); S.done(cur); }
        if (!has_next) break;
#pragma unroll
        for (int a = 0; a < 2; ++a)
#pragma unroll
            for (int b = 0; b < 2; ++b)
#pragma unroll
                for (int m = 0; m < 4; ++m)
#pragma unroll
                    for (int n = 0; n < 2; ++n) acc[a][b][m][n] = (f32x4){0.f, 0.f, 0.f, 0.f};
        cur = nxt; cA = nA; cB = nB; ++ui;
        if constexpr (ALIGN_EPI) { if (wr == 1) PG8_BAR; }
    }
    PG8_WAIT_V(0);
    if constexpr (!ALIGN_EPI) { if (wr == 0) PG8_BAR; }
    PG8_BAR;
    if constexpr (Epi::AFTER_DRAIN) { E.fused(acc, cur, wr, wc, fr, fq, lds, wid, lane); S.done(cur); }
#undef PG8_SA
#undef PG8_SB
#undef PG8_STAGE
#undef PG8_LDA
#undef PG8_LDB
#undef PG8_MMA
#undef PG8_WAIT_V
#undef PG8_WAIT_L
#undef PG8_BAR
#undef PG8_SCHED
}
}

#define LAS __attribute__((address_space(3)))
typedef float f32x4 __attribute__((ext_vector_type(4)));
typedef float f32x16 __attribute__((ext_vector_type(16)));
typedef short bf16x8 __attribute__((ext_vector_type(8)));
typedef unsigned u32x4 __attribute__((ext_vector_type(4)));
typedef unsigned u32x2 __attribute__((ext_vector_type(2)));

constexpr int LDS_BYTES = 147456 + 256;
constexpr size_t WS_BAR = 900 * 1024;
constexpr int NPHASE = 8;

struct Params { const float* in[25]; float* out; unsigned char* ws; int ph_lo, ph_hi; };
typedef const __attribute__((address_space(4))) Params* KP;
__device__ __forceinline__ KP kargs() { unsigned long long k = (unsigned long long)__builtin_amdgcn_kernarg_segment_ptr(); asm volatile("" : "+s"(k)); return (KP)k; }

__device__ __forceinline__ float wave_sum(float v) {
#pragma unroll
    for (int o = 1; o < 64; o <<= 1) v += __shfl_xor(v, o);
    return v;
}
__device__ __forceinline__ unsigned pk2(float lo, float hi) { return pg8::cvt_pk_bf16(lo, hi); }

__device__ __forceinline__ void sincos_small(float x, float& s, float& c) {
    const float k = rintf(x * 0.636619772367581343f);
    float r = fmaf(-k, 1.57079601287841796875f, x);
    r = fmaf(-k, 3.1391647326017846e-7f, r);
    r = fmaf(-k, 5.3903025299577648e-15f, r);
    const float r2 = r * r;
    float sp = fmaf(r2, 2.7183114939898219064e-6f, -1.9839334836096632576e-4f); sp = fmaf(sp, r2, 8.3333293858894631756e-3f); sp = fmaf(sp, r2, -1.6666665896820998054e-1f);
    const float sn = fmaf(r * r2, sp, r);
    float cp = fmaf(r2, 2.4433157118340246e-5f, -1.3887316255899256e-3f); cp = fmaf(cp, r2, 4.1666645655422476e-2f); cp = fmaf(cp, r2, -0.5f);
    const float cs = fmaf(cp, r2, 1.0f);
    const int q = ((int)k) & 3;
    const float s0 = (q & 1) ? cs : sn, c0 = (q & 1) ? sn : cs;
    s = (q & 2) ? -s0 : s0;
    c = ((q + 1) & 2) ? -c0 : c0;
}

template <int MAP>
__device__ __forceinline__ int dest_row(int n0) {
    if (MAP == 1) { const int pn = n0 >> 8, x = n0 & 255, wc = x >> 6, bj = (x >> 5) & 1; return (pn << 8) + (bj << 7) + (wc << 5); }
    if (MAP == 2) { const int bj = n0 >= DFF ? 1 : 0, rem = n0 - bj * DFF, pn = rem >> 7, x = rem & 127; return (pn << 8) + (bj << 7) + x; }
    return n0;
}
template <int MAP>
__device__ __forceinline__ void p0_transpose_item(const float* W, int K, int N, bf16* WT, LAS float* scr, int item, int lane) {
    const int nblk = N / 32, kb = item / nblk, nb = item % nblk, k0 = 64 * kb, n0 = 32 * nb;
    float wv[32];
#pragma unroll
    for (int i = 0; i < 32; ++i) wv[i] = __builtin_nontemporal_load(W + (size_t)(k0 + 2 * i + (lane >> 5)) * N + n0 + (lane & 31));
#pragma unroll
    for (int i = 0; i < 32; ++i) scr[(2 * i + (lane >> 5)) * 33 + (lane & 31)] = wv[i];
    asm volatile("s_waitcnt lgkmcnt(0)" ::: "memory");
    const int c = lane & 7; const int dr = dest_row<MAP>(n0);
#pragma unroll
    for (int j = 0; j < 4; ++j) { const int n = (lane >> 3) + 8 * j; const LAS float* s = scr + (8 * c) * 33 + n;
        u32x4 o; o.x = pk2(s[0 * 33], s[1 * 33]); o.y = pk2(s[2 * 33], s[3 * 33]); o.z = pk2(s[4 * 33], s[5 * 33]); o.w = pk2(s[6 * 33], s[7 * 33]);
        *(u32x4*)(WT + (size_t)(dr + n) * K + k0 + 8 * c) = o; }
    asm volatile("s_waitcnt lgkmcnt(0)" ::: "memory");
}

__device__ __forceinline__ void p0_ada(KP P, LAS unsigned char* lds, int tid, int lane, int wave) {
    unsigned char* ws = P->ws;
    const int G = gridDim.x, bx = blockIdx.x;
    const int gt = bx * 512 + tid, NGT = G * 512;
    for (int i = gt; i < NTOK; i += NGT) ((f32x4*)(ws + WS_SSQ))[i] = (f32x4){0.f, 0.f, 0.f, 0.f};
    if (bx == G - 1) {
        for (int i = tid; i < 1024; i += 512) {
            const int pos = i >> 4, f = i & 15;
            const float inv = exp2f(-(float)(2 * f) * (1.0f / 32.0f) * 13.287712379549449f);
            float s, c; sincos_small((float)pos * inv, s, c);
            ((float*)(ws + WS_ROPEC))[i] = c; ((float*)(ws + WS_ROPES))[i] = s;
        }
    }
    LAS float* scond = (LAS float*)lds;
    LAS float* red = (LAS float*)(lds + 36864);
    const float* wada = P->in[8]; const float* bada = P->in[9]; float* mods = (float*)(ws + WS_MODS);
    bool have = false;
    for (int it = bx; it < 192; it += G) {
        const int n0 = it * 32, c4 = (lane & 7) * 4, rg = lane >> 3, kbase = wave * 128 + rg;
        f32x4 w[16];
#pragma unroll
        for (int i = 0; i < 16; ++i) w[i] = __builtin_nontemporal_load((const f32x4*)(wada + (size_t)(kbase + 8 * i) * 6144 + n0 + c4));
        if (!have) {
            for (int idx = tid; idx < 9216; idx += 512) { const int c = idx >> 10, k = idx & 1023; const float x = c == 0 ? P->in[5][k] : P->in[4][(c - 1) * 1024 + k]; scond[idx] = x / (1.0f + __expf(-x)); }
            have = true;
        }
        __syncthreads();
        f32x4 a[9];
#pragma unroll
        for (int c = 0; c < 9; ++c) a[c] = (f32x4){0.f, 0.f, 0.f, 0.f};
#pragma unroll
        for (int i = 0; i < 16; ++i) {
#pragma unroll
            for (int c = 0; c < 9; ++c) a[c] += w[i] * scond[c * 1024 + kbase + 8 * i]; }
#pragma unroll
        for (int c = 0; c < 9; ++c)
#pragma unroll
            for (int j = 0; j < 4; ++j) { float v = a[c][j]; v += __shfl_xor(v, 8); v += __shfl_xor(v, 16); v += __shfl_xor(v, 32); a[c][j] = v; }
        if (lane < 8) {
#pragma unroll
            for (int c = 0; c < 9; ++c) *(LAS f32x4*)(red + (wave * 9 + c) * 32 + c4) = a[c]; }
        __syncthreads();
        if (tid < 288) { const int c = tid >> 5, cl = tid & 31; float s = 0.f;
#pragma unroll
            for (int p = 0; p < 8; ++p) s += red[(p * 9 + c) * 32 + cl];
            mods[c * 6144 + n0 + cl] = s + bada[n0 + cl]; }
    }
    __syncthreads();
}

__device__ __forceinline__ void convert_job(KP P, LAS unsigned char* lds, int tid, int lane, int wave, int what, int rank, int nblk) {
    unsigned char* ws = P->ws;
    const int gt = rank * 512 + tid, NGT = nblk * 512;
    if (what & 1) {
        const float* ck = P->in[2]; bf16* Ks = (bf16*)(ws + WS_KS);
        for (int i = gt; i < 262144; i += NGT) {
            const int c = i & 7, s = (i >> 3) & 511, bhm = i >> 12;
            const f32x4 a = __builtin_nontemporal_load((const f32x4*)(ck + (size_t)i * 8)), b2 = __builtin_nontemporal_load((const f32x4*)(ck + (size_t)i * 8 + 4));
            u32x4 o; o.x = pk2(a[0], a[1]); o.y = pk2(a[2], a[3]); o.z = pk2(b2[0], b2[1]); o.w = pk2(b2[2], b2[3]);
            *(u32x4*)(Ks + ((size_t)bhm * 2560 + 2048 + s) * 64 + c * 8) = o;
        }
        const float* cv = P->in[3]; bf16* VTs = (bf16*)(ws + WS_VTS);
        for (int i = gt; i < 262144; i += NGT) {
            const int sc = ((i >> 10) & 7) * 8 + (i & 7), dv = (i >> 3) & 127, bh = i >> 13;
            const float* src = cv + ((size_t)bh * 512 + sc * 8) * 128 + dv;
            float v8[8];
#pragma unroll
            for (int j = 0; j < 8; ++j) v8[j] = __builtin_nontemporal_load(src + 128 * j);
            asm volatile("" ::: "memory");
            u32x4 o; o.x = pk2(v8[0], v8[1]); o.y = pk2(v8[2], v8[3]); o.z = pk2(v8[4], v8[5]); o.w = pk2(v8[6], v8[7]);
            *(u32x4*)(VTs + ((size_t)bh * 128 + dv) * 2560 + 2048 + sc * 8) = o;
        }
    }
    {
        LAS float* scr = (LAS float*)(lds + wave * 16384);
        const int gw = rank * 8 + wave, NGW = nblk * 8;
        const int I1 = (what & 2) ? 16 * 80 : 0, I2 = (what & 4) ? 16 * 32 : 0, I3 = (what & 8) ? 16 * 176 : 0, I4 = (what & 16) ? 44 * 32 : 0, NITEMS = I1 + I2 + I3 + I4;
        for (int it = gw; it < NITEMS; it += NGW) {
            int r = it;
            if (r < I1) { p0_transpose_item<1>(P->in[10], 1024, NIN, (bf16*)(ws + WS_W1T), scr, r, lane); continue; } r -= I1;
            if (r < I2) { p0_transpose_item<0>(P->in[22], 1024, 1024, (bf16*)(ws + WS_W2T), scr, r, lane); continue; } r -= I2;
            if (r < I3) { p0_transpose_item<2>(P->in[23], 1024, 2 * DFF, (bf16*)(ws + WS_W3T), scr, r, lane); continue; } r -= I3;
            p0_transpose_item<0>(P->in[24], DFF, 1024, (bf16*)(ws + WS_W4T), scr, r, lane);
        }
    }
}

template <bool BF>
__device__ __forceinline__ void norm_phase(const float* xp, const float* xs, const float* g, const float* mods, int shift_off, int scale_off, bf16* XM, int lane, int wave) {
    const int gw = blockIdx.x * 8 + wave, NGW = gridDim.x * 8;
    constexpr int R = 3;
    for (int m0 = gw * R; m0 < NTOK; m0 += NGW * R) {
        f32x4 v[R][4];
#pragma unroll
        for (int rr = 0; rr < R; ++rr) { const int m = m0 + rr;
            if (BF) {
                const u32x2* xr = (const u32x2*)((const bf16*)xp + (size_t)m * DM) + lane;
#pragma unroll
                for (int j = 0; j < 4; ++j) { const u32x2 w = __builtin_nontemporal_load(xr + 64 * j);
                    v[rr][j] = (f32x4){__uint_as_float(w.x << 16), __uint_as_float(w.x & 0xffff0000u), __uint_as_float(w.y << 16), __uint_as_float(w.y & 0xffff0000u)}; }
            } else {
                const float* xrow = m < NPROMPT ? xp + (size_t)m * DM : xs + (size_t)(m - NPROMPT) * DM;
                const f32x4* xr = (const f32x4*)xrow + lane;
#pragma unroll
                for (int j = 0; j < 4; ++j) v[rr][j] = __builtin_nontemporal_load(xr + 64 * j);
            } }
#pragma unroll
        for (int rr = 0; rr < R; ++rr) { const int m = m0 + rr;
            const int cond = m < NPROMPT ? 0 : 1 + ((m - NPROMPT) >> 11);
            float s = 0.f;
#pragma unroll
            for (int j = 0; j < 4; ++j) { const f32x4 q = v[rr][j] * v[rr][j]; s += (q[0] + q[1]) + (q[2] + q[3]); }
            const float rstd = rsqrtf(wave_sum(s) * (1.0f / DM) + 1e-6f);
            const float* sh = mods + cond * 6144 + shift_off; const float* sc = mods + cond * 6144 + scale_off;
            u32x2* o8 = (u32x2*)(XM + (size_t)m * DM) + lane;
#pragma unroll
            for (int j = 0; j < 4; ++j) {
                const f32x4 gg = ((const f32x4*)g)[lane + 64 * j], s1 = ((const f32x4*)sc)[lane + 64 * j], h1 = ((const f32x4*)sh)[lane + 64 * j];
                const f32x4 y = v[rr][j] * rstd * gg * (1.0f + s1) + h1;
                u32x2 w; w.x = pk2(y[0], y[1]); w.y = pk2(y[2], y[3]); o8[64 * j] = w;
            }
        }
    }
}

__device__ __forceinline__ void sgu_phase(KP P, LAS unsigned char* lds, int tid, int lane, int wave) {
    unsigned char* ws = P->ws;
    const float* ssq = (const float*)(ws + WS_SSQ);
    const bf16* U = (const bf16*)(ws + WS_U);
    bf16* MIX = (bf16*)(ws + WS_XM);
    const float* sng = P->in[18]; const float* sw = P->in[19]; const float* sb = P->in[20]; const float* mog = P->in[21];
    const int r = lane & 31, h = lane >> 5, pb = wave & 3, ch2 = wave >> 2;
    constexpr int TP = 272;
    LAS unsigned char* A = lds;
    LAS unsigned char* B = lds + 32768;
    LAS unsigned char* UT = lds + 65536;
    LAS unsigned char* OT = lds + 65536 + 128 * TP;
    LAS float* red = (LAS float*)(lds + 65536 + 256 * TP);
    LAS float* rsq = red + 256;
    LAS float* rstv = rsq + 512;
    for (int ck = blockIdx.x; ck < 192; ck += gridDim.x) {
        const bool prompt = ck < 64;
        const int b = prompt ? (ck >> 1) : ((ck - 64) >> 4), s0 = prompt ? ((ck & 1) << 7) : (((ck - 64) & 15) << 7), Sx = prompt ? 256 : 2048;
        const bf16* GVT = prompt ? (const bf16*)(ws + WS_GVTP) : (const bf16*)(ws + WS_GVTS);
        const int tok0 = ck * 128;
        __syncthreads();
        { const int q = tid >> 2, g = tid & 3; rsq[g * 128 + q] = rsqrtf(ssq[(size_t)(tok0 + q) * 4 + g] * (1.0f / 128.0f) + 1e-6f); }
        const int p = pb * 32 + r;
        float ss = 0.f;
#pragma unroll 1
        for (int g = 0; g < 4; ++g) {
            __syncthreads();
#pragma unroll
            for (int i = 0; i < 4; ++i) { const int q = tid + 512 * i, c = q >> 4, cc = q & 15;
                const u32x4 v = __builtin_nontemporal_load((const u32x4*)(GVT + ((size_t)b * 512 + g * 128 + c) * Sx + s0 + cc * 8));
                const u32x4 uu = __builtin_nontemporal_load((const u32x4*)(U + (size_t)(tok0 + c) * 512 + g * 128 + cc * 8));
                *(LAS u32x4*)(A + c * 256 + ((cc ^ (c & 15)) << 4)) = v;
                *(LAS u32x4*)(UT + c * TP + cc * 16) = uu; }
            asm volatile("" ::: "memory");
#pragma unroll
            for (int i = 0; i < 8; ++i) { const int idx = tid + 512 * i, pp = idx >> 5, q4 = (idx & 31) << 2;
                const f32x4 w = *(const f32x4*)(sw + (size_t)g * 16384 + pp * 128 + q4);
                const f32x4 rs = *(const LAS f32x4*)(rsq + g * 128 + q4);
                const f32x4 y = w * rs; u32x2 o; o.x = pk2(y[0], y[1]); o.y = pk2(y[2], y[3]);
                const int cc = q4 >> 3;
                *(LAS u32x2*)(B + pp * 256 + ((cc ^ (pp & 15)) << 4) + ((q4 & 4) << 1)) = o;
                if (i == 3) asm volatile("" ::: "memory"); }
            __syncthreads();
            f32x16 acc[2]; acc[0] = (f32x16)(0.f); acc[1] = (f32x16)(0.f);
#pragma unroll
            for (int ks = 0; ks < 8; ++ks) {
                const bf16x8 bw = *(const LAS bf16x8*)(B + p * 256 + (((2 * ks + h) ^ (p & 15)) << 4));
#pragma unroll
                for (int t = 0; t < 2; ++t) { const int crow = (ch2 * 2 + t) * 32 + r;
                    const bf16x8 ag = *(const LAS bf16x8*)(A + crow * 256 + (((2 * ks + h) ^ (crow & 15)) << 4));
                    acc[t] = __builtin_amdgcn_mfma_f32_32x32x16_bf16(ag, bw, acc[t], 0, 0, 0); }
            }
            const float bp = sb[g * 128 + p];
#pragma unroll
            for (int t = 0; t < 2; ++t)
#pragma unroll
                for (int q = 0; q < 4; ++q) {
                    const int c = (ch2 * 2 + t) * 32 + 8 * q + 4 * h;
                    const f32x4 gn = *(const f32x4*)(sng + g * 128 + c);
                    const u32x2 uu = *(const LAS u32x2*)(UT + p * TP + c * 2);
                    float uf[4]; uf[0] = __uint_as_float(uu.x << 16); uf[1] = __uint_as_float(uu.x & 0xffff0000u); uf[2] = __uint_as_float(uu.y << 16); uf[3] = __uint_as_float(uu.y & 0xffff0000u);
                    float v[4];
#pragma unroll
                    for (int j = 0; j < 4; ++j) { v[j] = uf[j] * fmaf(gn[j], acc[t][4 * q + j], bp); ss = fmaf(v[j], v[j], ss); }
                    u32x2 o; o.x = pk2(v[0], v[1]); o.y = pk2(v[2], v[3]);
                    *(LAS u32x2*)(OT + p * TP + c * 2) = o;
                }
            __syncthreads();
#pragma unroll
            for (int i = 0; i < 4; ++i) { const int q = tid + 512 * i, row = q >> 4, cc = q & 15;
                *(u32x4*)(MIX + (size_t)(tok0 + row) * 1024 + 512 + g * 128 + cc * 8) = *(const LAS u32x4*)(OT + row * TP + cc * 16); }
        }
        ss += __shfl_xor(ss, 32);
        if (h == 0) red[ch2 * 128 + p] = ss;
        __syncthreads();
        if (tid < 128) rstv[tid] = rsqrtf((red[tid] + red[128 + tid]) * (1.0f / 512.0f) + 1e-6f);
        __syncthreads();
#pragma unroll 4
        for (int i = 0; i < 16; ++i) { const int q = tid + 512 * i, row = q >> 6, cc = q & 63;
            u32x4* mp = (u32x4*)(MIX + (size_t)(tok0 + row) * 1024 + 512 + cc * 8);
            const u32x4 x = *mp; const float rs = rstv[row];
            const f32x4 m0 = *(const f32x4*)(mog + cc * 8), m1 = *(const f32x4*)(mog + cc * 8 + 4);
            u32x4 o;
            o.x = pk2(__uint_as_float(x.x << 16) * rs * m0[0], __uint_as_float(x.x & 0xffff0000u) * rs * m0[1]);
            o.y = pk2(__uint_as_float(x.y << 16) * rs * m0[2], __uint_as_float(x.y & 0xffff0000u) * rs * m0[3]);
            o.z = pk2(__uint_as_float(x.z << 16) * rs * m1[0], __uint_as_float(x.z & 0xffff0000u) * rs * m1[1]);
            o.w = pk2(__uint_as_float(x.w << 16) * rs * m1[2], __uint_as_float(x.w & 0xffff0000u) * rs * m1[3]);
            *mp = o; }
    }
    __syncthreads();
}

__device__ __forceinline__ float max3f(float a, float b, float c) { float r; asm("v_max3_f32 %0, %1, %2, %3" : "=v"(r) : "v"(a), "v"(b), "v"(c)); return r; }
__device__ __forceinline__ void attn_unit(LAS unsigned char* lds, const bf16* Qb, int Sq, int q0, const bf16* Kb, const bf16* VTb, int Sk,
                                          bf16* mixp, const float* gout, float lam, int tid, int lane, int wave, int tmul = 1) {
    const int r = lane & 31, h = lane >> 5, qsub = wave >> 1, map = wave & 1;
    const int nt = Sk >> 6;
    bf16x8 qf[4];
    { const bf16* qp = Qb + ((size_t)map * Sq + q0 + qsub * 32 + r) * 64 + 8 * h;
#pragma unroll
      for (int ks = 0; ks < 4; ++ks) qf[ks] = *(const bf16x8*)(qp + 16 * ks); }
    const bf16* K1 = Kb; const bf16* K2 = Kb + (size_t)Sk * 64;
    const int srow = tid >> 3, sc = tid & 7;
    const int so = srow * 128 + ((sc ^ ((srow >> 1) & 7)) << 4);
    const bf16* gk1 = K1 + tid * 8; const bf16* gk2 = K2 + tid * 8;
    const bf16* gv0 = VTb + (size_t)srow * Sk + sc * 8; const bf16* gv1 = gv0 + (size_t)64 * Sk;
    const int kr = (r & 19) | ((r & 4) << 1) | ((r & 8) >> 1);
    const int kx = (h ^ ((kr >> 1) & 7)) << 4, koff = map * 8192 + kr * 128;
    const int vx = (h ^ ((r >> 1) & 7)) << 4, voff = 16384 + r * 128;
    f32x16 O[4];
#pragma unroll
    for (int i = 0; i < 4; ++i) O[i] = (f32x16)(0.f);
    float mrun = -1e30f, lsum = 0.f;
    const float C = 0.18033688011112042f;
    const float TLAZY = 8.0f / 0.18033688011112042f;
    u32x4 st0, st1, st2, st3;
    st0 = *(const u32x4*)gk1; st1 = *(const u32x4*)gk2; st2 = *(const u32x4*)gv0; st3 = *(const u32x4*)gv1;
    *(LAS u32x4*)(lds + so) = st0; *(LAS u32x4*)(lds + 8192 + so) = st1; *(LAS u32x4*)(lds + 16384 + so) = st2; *(LAS u32x4*)(lds + 24576 + so) = st3;
    __syncthreads();
    for (int t = 0; t < nt; ++t) {
        LAS unsigned char* buf = lds + ((t & 1) << 15);
        const bool p1 = t + 1 < nt;
        if (p1) { const int e = (t + 1) * tmul * 64;
            st0 = *(const u32x4*)(gk1 + (size_t)e * 64); st1 = *(const u32x4*)(gk2 + (size_t)e * 64); st2 = *(const u32x4*)(gv0 + e); st3 = *(const u32x4*)(gv1 + e); }
        bf16x8 fa[8], fb[8];
#pragma unroll
        for (int ks = 0; ks < 4; ++ks) { const int co = ((2 * ks) << 4) ^ kx; fa[2 * ks] = *(const LAS bf16x8*)(buf + koff + co); fa[2 * ks + 1] = *(const LAS bf16x8*)(buf + koff + 4096 + co); }
        __builtin_amdgcn_sched_barrier(0);
        f32x16 S0 = (f32x16)(0.f), S1 = (f32x16)(0.f);
#pragma unroll
        for (int ks = 0; ks < 4; ++ks) { S0 = __builtin_amdgcn_mfma_f32_32x32x16_bf16(fa[2 * ks], qf[ks], S0, 0, 0, 0); S1 = __builtin_amdgcn_mfma_f32_32x32x16_bf16(fa[2 * ks + 1], qf[ks], S1, 0, 0, 0); }
#pragma unroll
        for (int kk = 0; kk < 2; ++kk) { const int co = ((2 * kk) << 4) ^ vx;
#pragma unroll
            for (int d = 0; d < 4; ++d) fb[kk * 4 + d] = *(const LAS bf16x8*)(buf + voff + d * 4096 + co); }
        __builtin_amdgcn_sched_barrier(0);
        float mx; { float m0 = max3f(S0[0], S0[1], S0[2]), m1 = max3f(S0[3], S0[4], S0[5]), m2 = max3f(S0[6], S0[7], S0[8]), m3 = max3f(S0[9], S0[10], S0[11]);
            float m4 = max3f(S0[12], S0[13], S0[14]), m5 = max3f(S0[15], S1[0], S1[1]), m6 = max3f(S1[2], S1[3], S1[4]), m7 = max3f(S1[5], S1[6], S1[7]);
            float m8 = max3f(S1[8], S1[9], S1[10]), m9 = max3f(S1[11], S1[12], S1[13]), m10 = max3f(S1[14], S1[15], m0);
            m1 = max3f(m1, m2, m3); m4 = max3f(m4, m5, m6); m7 = max3f(m7, m8, m9); mx = max3f(m1, m4, m7); mx = max3f(mx, m10, m10); }
        { const u32x2 sw2 = __builtin_amdgcn_permlane32_swap(__float_as_uint(mx), __float_as_uint(mx), false, false); mx = max3f(__uint_as_float(sw2.x), __uint_as_float(sw2.y), mx); }
        if (__builtin_amdgcn_ballot_w64(mx > mrun + TLAZY) != 0ull) {
            const float mnew = (mx > mrun + TLAZY) ? mx : mrun; const float alpha = __builtin_amdgcn_exp2f((mrun - mnew) * C);
            mrun = mnew; lsum *= alpha;
#pragma unroll
            for (int d = 0; d < 4; ++d) O[d] = O[d] * alpha; }
        { const float mc = mrun * C; S0 = S0 * C - mc; S1 = S1 * C - mc; }
#pragma unroll
        for (int i = 0; i < 16; ++i) { S0[i] = __builtin_amdgcn_exp2f(S0[i]); S1[i] = __builtin_amdgcn_exp2f(S1[i]); }
        { const f32x16 sv = S0 + S1;
          lsum += ((sv[0] + sv[1]) + (sv[2] + sv[3])) + ((sv[4] + sv[5]) + (sv[6] + sv[7])) + (((sv[8] + sv[9]) + (sv[10] + sv[11])) + ((sv[12] + sv[13]) + (sv[14] + sv[15]))); }
        bf16x8 pf[4];
#pragma unroll
        for (int s2 = 0; s2 < 2; ++s2) { u32x4 w0, w1;
            w0.x = pk2(S0[8 * s2 + 0], S0[8 * s2 + 1]); w0.y = pk2(S0[8 * s2 + 2], S0[8 * s2 + 3]); w0.z = pk2(S0[8 * s2 + 4], S0[8 * s2 + 5]); w0.w = pk2(S0[8 * s2 + 6], S0[8 * s2 + 7]);
            w1.x = pk2(S1[8 * s2 + 0], S1[8 * s2 + 1]); w1.y = pk2(S1[8 * s2 + 2], S1[8 * s2 + 3]); w1.z = pk2(S1[8 * s2 + 4], S1[8 * s2 + 5]); w1.w = pk2(S1[8 * s2 + 6], S1[8 * s2 + 7]);
            pf[s2] = __builtin_bit_cast(bf16x8, w0); pf[2 + s2] = __builtin_bit_cast(bf16x8, w1); }
        __builtin_amdgcn_sched_barrier(0);
#pragma unroll
        for (int kk = 2; kk < 4; ++kk) { const int co = ((2 * kk) << 4) ^ vx;
#pragma unroll
            for (int d = 0; d < 4; ++d) fa[(kk - 2) * 4 + d] = *(const LAS bf16x8*)(buf + voff + d * 4096 + co); }
        __builtin_amdgcn_sched_barrier(0);
#pragma unroll
        for (int kk = 0; kk < 2; ++kk)
#pragma unroll
            for (int d = 0; d < 4; ++d) O[d] = __builtin_amdgcn_mfma_f32_32x32x16_bf16(fb[kk * 4 + d], pf[kk], O[d], 0, 0, 0);
#pragma unroll
        for (int kk = 2; kk < 4; ++kk)
#pragma unroll
            for (int d = 0; d < 4; ++d) O[d] = __builtin_amdgcn_mfma_f32_32x32x16_bf16(fa[(kk - 2) * 4 + d], pf[kk], O[d], 0, 0, 0);
        if (p1) { LAS unsigned char* nb = lds + (((t + 1) & 1) << 15);
            *(LAS u32x4*)(nb + so) = st0; *(LAS u32x4*)(nb + 8192 + so) = st1; *(LAS u32x4*)(nb + 16384 + so) = st2; *(LAS u32x4*)(nb + 24576 + so) = st3; }
        __syncthreads();
    }
    const float l = lsum + __shfl_xor(lsum, 32);
    LAS float* comb = (LAS float*)(lds + 65536 + qsub * 16384);
    if (map == 1) {
        const float f = lam / l;
#pragma unroll
        for (int d = 0; d < 4; ++d)
#pragma unroll
            for (int i = 0; i < 16; ++i) comb[(d * 16 + i) * 64 + lane] = O[d][i] * f;
    }
    __syncthreads();
    if (map == 0) {
        const float inv = 1.0f / l; float ss = 0.f;
#pragma unroll
        for (int d = 0; d < 4; ++d)
#pragma unroll
            for (int i = 0; i < 16; ++i) { const float o = fmaf(O[d][i], inv, -comb[(d * 16 + i) * 64 + lane]); O[d][i] = o; ss = fmaf(o, o, ss); }
        ss += __shfl_xor(ss, 32);
        const float rs = rsqrtf(ss * (1.0f / 128.0f) + 1e-6f) * 0.8f;
        int r2 = r; asm volatile("" : "+v"(r2));
        LAS unsigned char* ot = lds + (qsub * 32 + r2) * 272;
#pragma unroll
        for (int d = 0; d < 4; ++d)
#pragma unroll
            for (int q = 0; q < 4; ++q) {
                const int dv = 32 * d + 8 * q + 4 * h;
                const f32x4 gg = *(const f32x4*)(gout + dv);
                u32x2 o; o.x = pk2(O[d][4 * q] * rs * gg[0], O[d][4 * q + 1] * rs * gg[1]); o.y = pk2(O[d][4 * q + 2] * rs * gg[2], O[d][4 * q + 3] * rs * gg[3]);
                *(LAS u32x2*)(ot + dv * 2) = o;
                if (q & 1) asm volatile("" ::: "memory");
            }
    }
    __syncthreads();
    int t2 = tid; asm volatile("" : "+v"(t2));
#pragma unroll
    for (int i = 0; i < 4; ++i) { const int q = t2 + 512 * i, row = q >> 4, cc = q & 15;
        *(u32x4*)(mixp + (size_t)row * 1024 + cc * 8) = *(const LAS u32x4*)(lds + row * 272 + cc * 16); }
    __syncthreads();
}

__device__ __forceinline__ void attn_phase(KP P, LAS unsigned char* lds, int tid, int lane, int wave, bool shadow = false, int tmul = 1) {
    unsigned char* ws = P->ws;
    const float d1 = wave_sum(P->in[13][lane] * P->in[14][lane]), d2 = wave_sum(P->in[15][lane] * P->in[16][lane]);
    const float lam = __expf(d1) - __expf(d2) + 0.2f;
    bf16* MIX = shadow ? (bf16*)(ws + 206 * MiB) : (bf16*)(ws + WS_XM);
    const float* aog = P->in[17];
    const int G = gridDim.x, bx = blockIdx.x;
    const int n_items = (G == 256) ? (bx >= 192 ? 6 : 2) : 0;
    for (int it = 0, j = bx; (G == 256) ? (it < n_items) : (j < 768); ++it, j += G) {
        int jj = j;
        if (G == 256) jj = it < 2 ? bx + 256 * it : 512 + (bx - 192) * 4 + (it - 2);
        if (jj < 512) {
            const int x = jj & 7, idx = jj >> 3, grp = x * 4 + (idx >> 4), qb = idx & 15, b = grp >> 2, hh = grp & 3;
            attn_unit(lds, (const bf16*)(ws + WS_QS) + (size_t)(b * 4 + hh) * 2 * 2048 * 64, 2048, qb * 128,
                      (const bf16*)(ws + WS_KS) + (size_t)(b * 4 + hh) * 2 * 2560 * 64, (const bf16*)(ws + WS_VTS) + ((size_t)b * 512 + hh * 128) * 2560, 2560,
                      MIX + ((size_t)NPROMPT + b * 2048 + qb * 128) * 1024 + hh * 128, aog + hh * 128, lam, tid, lane, wave, tmul);
        } else {
            const int k = jj - 512, grp = k >> 1, qb = k & 1, b = grp >> 2, hh = grp & 3;
            attn_unit(lds, (const bf16*)(ws + WS_QP) + (size_t)(b * 4 + hh) * 2 * 256 * 64, 256, qb * 128,
                      (const bf16*)(ws + WS_KP) + (size_t)(b * 4 + hh) * 2 * 256 * 64, (const bf16*)(ws + WS_VTP) + ((size_t)b * 512 + hh * 128) * 256, 256,
                      MIX + ((size_t)b * 256 + qb * 128) * 1024 + hh * 128, aog + hh * 128, lam, tid, lane, wave, tmul);
        }
    }
}

#define RLX_AGENT __ATOMIC_RELAXED, __HIP_MEMORY_SCOPE_AGENT
#define XB_TMO      128
#define XB_XCNT(j)  (256  + 64 * (j))
#define XB_XSUB(j)  (1280 + 64 * (j))
#define XB_XGEN(j)  (2304 + 64 * (j))
#define XB_TOP      3328
#define XB_TOPGEN   3392
#define XCD_BAR_WORDS 3456
#define XB_SPIN_CAP (1u << 18)

__device__ __forceinline__ unsigned xb_ld(unsigned* p)              { return __hip_atomic_load(p, __ATOMIC_RELAXED, __HIP_MEMORY_SCOPE_AGENT); }
__device__ __forceinline__ unsigned xb_add(unsigned* p, unsigned v) { return __hip_atomic_fetch_add(p, v, __ATOMIC_RELAXED, __HIP_MEMORY_SCOPE_AGENT); }
__device__ __forceinline__ unsigned xb_xcc_id() { return (unsigned)__builtin_amdgcn_s_getreg((3 << 11) | 20) & 0xFu; }
#define XB_SPIN(cond, bar) do { unsigned _sp = 0; while (cond) { __builtin_amdgcn_s_sleep(1); \
    if ((++_sp & 255u) == 0u) { if (xb_ld(&(bar)[XB_TMO])) break; if (_sp > XB_SPIN_CAP) { atomicAdd(&(bar)[XB_TMO], 1u); break; } } } } while (0)

struct XcdBarrier {
    unsigned* bar; unsigned x;
    volatile LAS unsigned* st;
};

__device__ __forceinline__ XcdBarrier xcd_barrier_post(unsigned* bar, volatile LAS unsigned* st) {
    XcdBarrier b; b.bar = bar; b.x = xb_xcc_id(); b.st = st;
    if (threadIdx.x == 0) (void)xb_add(&bar[XB_XCNT(b.x)], 1u);
    return b;
}
__device__ __forceinline__ void xcd_barrier_complete(unsigned* bar, unsigned x, unsigned& nloc, unsigned& nx) {
    const unsigned G = gridDim.x * gridDim.y * gridDim.z;
    unsigned sum, cnt, mine, sp = 0u;
    for (;;) {
        sum = 0u; cnt = 0u; mine = 0u;
#pragma unroll
        for (unsigned j = 0; j < 16; ++j) { const unsigned c = xb_ld(&bar[XB_XCNT(j)]); sum += c; cnt += (c > 0u) ? 1u : 0u; mine = (j == x) ? c : mine; }
        if (sum == G) break;
        __builtin_amdgcn_s_sleep(1);
        if ((++sp & 255u) == 0u) { if (xb_ld(&bar[XB_TMO])) break; if (sp > XB_SPIN_CAP) { atomicAdd(&bar[XB_TMO], 1u); break; } }
    }
    nloc = mine > 0u ? mine : 1u; nx = cnt > 0u ? cnt : 1u;
}

__device__ __forceinline__ void xcd_barrier(const XcdBarrier& b) {
    asm volatile("s_waitcnt vmcnt(0)" ::: "memory");
    __syncthreads();
    if (threadIdx.x == 0) {
        unsigned* bar = b.bar;
        __builtin_amdgcn_s_waitcnt(0);
        unsigned nloc = b.st[0], nx = b.st[1];
        if (nloc == 0u) { xcd_barrier_complete(bar, b.x, nloc, nx); b.st[0] = nloc; b.st[1] = nx; }
        const unsigned old = xb_add(&bar[XB_XSUB(b.x)], 1u);
        const unsigned gen = old / nloc;
        if (old + 1u == (gen + 1u) * nloc) {
            __builtin_amdgcn_fence(__ATOMIC_RELEASE, "agent");
            asm volatile("s_waitcnt vmcnt(0)" ::: "memory");
            const unsigned og = xb_add(&bar[XB_TOP], 1u);
            const unsigned tg = og / nx;
            if (og + 1u == (tg + 1u) * nx) xb_add(&bar[XB_TOPGEN], 1u);
            else XB_SPIN(xb_ld(&bar[XB_TOPGEN]) == tg, bar);
            __builtin_amdgcn_fence(__ATOMIC_ACQUIRE, "agent");
            xb_add(&bar[XB_XGEN(b.x)], 1u);
            asm volatile("s_waitcnt vmcnt(0)" ::: "memory");
        } else {
            XB_SPIN(xb_ld(&bar[XB_XGEN(b.x)]) == gen, bar);
            __builtin_amdgcn_fence(__ATOMIC_ACQUIRE, "agent");
            asm volatile("s_waitcnt vmcnt(0)" ::: "memory");
        }
    }
    __syncthreads();
}

__global__ void __launch_bounds__(512, 2) fwd_megakernel(Params Parg) {
    extern __shared__ __attribute__((aligned(16))) unsigned char lds_raw[];
    LAS unsigned char* lds = (LAS unsigned char*)lds_raw;
    const int tid = threadIdx.x, lane = tid & 63, wave = __builtin_amdgcn_readfirstlane(tid >> 6);
    int lo, hi; XcdBarrier xbar;
    { KP P = kargs(); lo = P->ph_lo; hi = P->ph_hi;
      volatile LAS unsigned* bst = (volatile LAS unsigned*)(lds + 147456);
      if (tid == 0) { bst[0] = 0u; bst[1] = 0u; }
      __syncthreads();
      xbar = xcd_barrier_post((unsigned*)(P->ws + WS_BAR), bst); }
#define IN(k) (lo <= (k) && (k) < hi)
#define SEAM(k) do { if (IN(k) && IN((k) + 1)) { xcd_barrier(xbar); } } while (0)
    if (hi > NPHASE + 1) cg::this_grid().sync();
    if (IN(0)) { KP P = kargs(); p0_ada(P, lds, tid, lane, wave); }
    SEAM(0);
    const bool defer = gridDim.x == 256;
    if (IN(1)) { KP P = kargs(); convert_job(P, lds, tid, lane, wave, defer ? 2 : 31, (int)blockIdx.x, (int)gridDim.x); }
    if (IN(1)) { KP P = kargs(); unsigned char* ws = P->ws; norm_phase<false>(P->in[0], P->in[1], P->in[6], (const float*)(ws + WS_MODS), 0, 1024, (bf16*)(ws + WS_XM), lane, wave); }
    SEAM(1);
    if (IN(2)) {
        KP P = kargs(); unsigned char* ws = P->ws;
        pg8::Gemm g{(const bf16*)(ws + WS_XM), (const bf16*)(ws + WS_W1T), NTOK, NIN, 1024}; pg8::StaticOrder S; S.init(NTOK, NIN, (int)gridDim.x, (int)blockIdx.x);
        pg8::EpiIn E{ws, P->out, P->in[11], P->in[12]};
        pg8::gemm_phase<pg8::EpiIn, pg8::StaticOrder, true, true>(lds, g, S, E);
    }
    if (IN(2) && defer && blockIdx.x >= 192) { KP P = kargs(); convert_job(P, lds, tid, lane, wave, 1 | 4, (int)blockIdx.x - 192, 64); }
    SEAM(2);
    if (IN(3)) { KP P = kargs(); sgu_phase(P, lds, tid, lane, wave); attn_phase(P, lds, tid, lane, wave); }
    SEAM(3);
    if (IN(4)) {
        KP P = kargs(); unsigned char* ws = P->ws;
        pg8::Gemm g{(const bf16*)(ws + WS_XM), (const bf16*)(ws + WS_W2T), NTOK, 1024, 1024}; pg8::StaticOrder S; S.init(NTOK, 1024, (int)gridDim.x, (int)blockIdx.x);
        pg8::EpiRes1 E{P->in[0], P->in[1], (bf16*)(ws + WS_X1B), (const float*)(ws + WS_MODS) + 2048};
        pg8::gemm_phase<pg8::EpiRes1, pg8::StaticOrder, true, true>(lds, g, S, E);
    }
    if (IN(4) && defer && blockIdx.x >= 128) { KP P = kargs(); convert_job(P, lds, tid, lane, wave, 8 | 16, (int)blockIdx.x - 128, 128); }
    SEAM(4);
    if (IN(5)) { KP P = kargs(); unsigned char* ws = P->ws; norm_phase<true>((const float*)(ws + WS_X1B), nullptr, P->in[7], (const float*)(ws + WS_MODS), 3072, 4096, (bf16*)(ws + WS_XM), lane, wave); }
    SEAM(5);
    if (IN(6)) {
        KP P = kargs(); unsigned char* ws = P->ws;
        pg8::Gemm g{(const bf16*)(ws + WS_XM), (const bf16*)(ws + WS_W3T), NTOK, 2 * DFF, 1024}; pg8::StaticOrder S; S.init(NTOK, 2 * DFF, (int)gridDim.x, (int)blockIdx.x);
        pg8::EpiSwiglu E{(bf16*)(ws + WS_HID)};
        pg8::gemm_phase<pg8::EpiSwiglu, pg8::StaticOrder, true, true>(lds, g, S, E);
    }
    SEAM(6);
    if (IN(7)) {
        KP P = kargs(); unsigned char* ws = P->ws; float* out = P->out;
        pg8::Gemm g{(const bf16*)(ws + WS_HID), (const bf16*)(ws + WS_W4T), NTOK, 1024, DFF}; pg8::StaticOrder S; S.init(NTOK, 1024, (int)gridDim.x, (int)blockIdx.x);
        pg8::EpiRes2 E{(const bf16*)(ws + WS_X1B), out + OUT_Y, (const float*)(ws + WS_MODS) + 5120};
        pg8::gemm_phase<pg8::EpiRes2, pg8::StaticOrder, true, true>(lds, g, S, E);
    }
#undef IN
#undef SEAM
}

extern "C" void kernel_launch(void* const* d_in, const int* in_sizes, int n_in, void* d_out, int out_size, void* d_ws, size_t ws_size, hipStream_t stream) {
    static int grid = 0;
    if (grid == 0) {
        if (n_in != 25 || ws_size < WS_END) { fprintf(stderr, "kernel_launch: built for 25 inputs and >= %zu bytes of workspace; got %d, %zu\n", (size_t)WS_END, n_in, ws_size); grid = -1; return; }
        int dev = 0, cus = 0, per_cu = 0;
        if (hipGetDevice(&dev) != hipSuccess || hipDeviceGetAttribute(&cus, hipDeviceAttributeMultiprocessorCount, dev) != hipSuccess) { grid = -1; return; }
        if (hipFuncSetAttribute((const void*)fwd_megakernel, hipFuncAttributeMaxDynamicSharedMemorySize, LDS_BYTES) != hipSuccess) { fprintf(stderr, "kernel_launch: hipFuncSetAttribute failed\n"); grid = -1; return; }
        if (hipOccupancyMaxActiveBlocksPerMultiprocessor(&per_cu, (const void*)fwd_megakernel, 512, LDS_BYTES) != hipSuccess || per_cu < 1) { fprintf(stderr, "kernel_launch: occupancy query says %d\n", per_cu); per_cu = 1; }
        (void)hipGetLastError();
        grid = cus * per_cu;
    }
    if (grid < 0) return;
    if (hipMemsetAsync((char*)d_ws + WS_BAR, 0, XCD_BAR_WORDS * 4, stream) != hipSuccess) { fprintf(stderr, "kernel_launch: hipMemsetAsync failed\n"); return; }
    Params p{};
    for (int i = 0; i < 25; ++i) p.in[i] = (const float*)d_in[i];
    p.out = (float*)d_out; p.ws = (unsigned char*)d_ws;
#if MK_N_LAUNCHES == 1
    p.ph_lo = 0; p.ph_hi = NPHASE;
    void* args[] = {&p};
    hipError_t e = hipLaunchCooperativeKernel((const void*)fwd_megakernel, dim3(grid), dim3(512), args, LDS_BYTES, stream);
    if (e != hipSuccess) fprintf(stderr, "kernel_launch: cooperative launch failed: %s (grid %d)\n", hipGetErrorString(e), grid);
#else
    for (int k = 0; k < NPHASE; ++k) {
        p.ph_lo = k; p.ph_hi = k + 1;
        hipLaunchKernelGGL(fwd_megakernel, dim3(grid), dim3(512), LDS_BYTES, stream, p);
    }
#endif
}
```

```cpp
#include <hip/hip_runtime.h>
#include <hip/hip_cooperative_groups.h>
#include <cstdio>
#include <cstdint>
namespace cg = cooperative_groups;

#ifndef MK_N_LAUNCHES
#define MK_N_LAUNCHES 1
#endif

typedef unsigned short bf16;
constexpr int NTOK = 24576, NPROMPT = 8192, DM = 1024, DFF = 2816, NIN = 2560;
constexpr size_t MiB = 1u << 20;
constexpr size_t WS_MODS = 0, WS_ROPEC = 256 * 1024, WS_ROPES = 260 * 1024, WS_SSQ = 512 * 1024;
constexpr size_t WS_W1T = 1 * MiB, WS_W2T = 6 * MiB, WS_W3T = 8 * MiB, WS_W4T = 19 * MiB;
constexpr size_t WS_XM = 25 * MiB;
constexpr size_t WS_A = 73 * MiB;
constexpr size_t WS_QP = WS_A, WS_QS = WS_A + 8 * MiB, WS_KP = WS_A + 24 * MiB, WS_KS = WS_A + 32 * MiB;
constexpr size_t WS_VTP = WS_A + 52 * MiB, WS_VTS = WS_A + 60 * MiB, WS_U = WS_A + 80 * MiB, WS_GVTP = WS_A + 104 * MiB, WS_GVTS = WS_A + 112 * MiB;
constexpr size_t WS_HID = WS_A, WS_X1B = 206 * MiB, WS_END = 254 * MiB;
static_assert(WS_GVTS + 16 * MiB <= WS_END && WS_END <= 256 * MiB, "workspace map");
constexpr size_t OUT_Y = 0, OUT_STK = (size_t)NTOK * DM, OUT_STV = OUT_STK + 4194304;

namespace pg8 {
#define PG8_LAS __attribute__((address_space(3)))
typedef unsigned short bf16_t;
typedef short bf16x8 __attribute__((ext_vector_type(8)));
typedef float f32x4 __attribute__((ext_vector_type(4)));
typedef unsigned u32x4 __attribute__((ext_vector_type(4)));
constexpr int BM = 256, BK = 64, HALF = 128, HTB = HALF * BK * 2  , STAGE_BYTES = 8 * HTB, NXCD = 8, WGM = 8;

__host__ __device__ __forceinline__ int lds_byte(int r, int c) { const int st = (r >> 4) * 2 + (c >> 5), rr = r & 15, cc = c & 31, ob = rr * 64 + cc * 2; return st * 1024 + (ob ^ (((ob >> 9) & 1) << 5)); }
__host__ __device__ __forceinline__ void stage_rc(int b, int& R, int& C) { const int st = b / 1024, sb = b % 1024, swz = sb ^ (((sb >> 9) & 1) << 5); R = (st >> 1) * 16 + swz / 64; C = (st & 1) * 32 + (swz % 64) / 2; }
__host__ __device__ __forceinline__ int perm32(int rho) { const int n = rho >> 4, i = rho & 15; return 8 * (i >> 2) + 4 * n + (i & 3); }

struct Unit { int pm, pn; };
struct Gemm { const bf16_t* A; const bf16_t* Bt; int M, N, K; };

struct StaticOrder {
    int nM, nN, nwg, G, c;
    __host__ __device__ void init(int M, int N, int G_, int c_) { nM = M / BM; nN = N / BM; nwg = nM * nN; G = G_; c = c_; }
    __host__ __device__ bool next(int i, Unit& u) const {
        const long L = (long)i * G + c; if (L >= nwg) return false;
        int wgid = (int)L; { const int q = nwg / NXCD, r = nwg % NXCD, xcd = wgid % NXCD, off = wgid / NXCD; wgid = (xcd < r ? xcd * (q + 1) : r * (q + 1) + (xcd - r) * q) + off; }
        const int nig = WGM * nN, gid = wgid / nig, fm = gid * WGM, gsz = (nM - fm) < WGM ? (nM - fm) : WGM;
        u.pm = fm + ((wgid % nig) % gsz); u.pn = (wgid % nig) / gsz; return true;
    }
    __device__ __forceinline__ void a_ready(const Unit&) const {}
    __device__ __forceinline__ void done(const Unit&) const {}
};

__device__ __forceinline__ unsigned cvt_pk_bf16(float lo, float hi) { unsigned r; asm volatile("v_cvt_pk_bf16_f32 %0, %1, %2" : "=v"(r) : "v"(lo), "v"(hi)); return r; }
typedef float f32x2 __attribute__((ext_vector_type(2)));
typedef unsigned u32x2 __attribute__((ext_vector_type(2)));
__device__ __forceinline__ u32x2 pack4(const f32x4 v) { u32x2 w; w.x = cvt_pk_bf16(v[0], v[1]); w.y = cvt_pk_bf16(v[2], v[3]); return w; }
__device__ __forceinline__ bf16_t bf1(float v) { return (bf16_t)(cvt_pk_bf16(v, 0.f) & 0xffffu); }

struct EpiIn {
    static constexpr bool PERM = false, AFTER_DRAIN = false;
    unsigned char* ws; float* out; const float *qg, *kg;
    __device__ __forceinline__ void operator()(const f32x4 (&acc)[2][2][4][2], const Unit& u, int wr, int wc, int fr, int fq) const {
        asm volatile("" : "+v"(fr), "+v"(fq));
        const int pm = u.pm, pn = u.pn;
        const bool prompt = pm < 32;
        const int b = prompt ? pm : ((pm - 32) >> 3);
        const int s0 = prompt ? 0 : (((pm - 32) & 7) << 8);
        const int kind = pn >> 1;
        const int chw = ((pn & 1) << 8) + (wc << 6);
        if (kind <= 1) {
            const int hm = chw >> 6;
            const float* gain = kind == 0 ? qg : kg;
            f32x4 g4[2][2];
#pragma unroll
            for (int bj = 0; bj < 2; ++bj)
#pragma unroll
                for (int n = 0; n < 2; ++n) g4[bj][n] = *(const f32x4*)(gain + 32 * bj + 16 * n + 4 * fq);
            const int Sx = prompt ? 256 : (kind == 0 ? 2048 : 2560);
            bf16_t* dst = (bf16_t*)(ws + (kind == 0 ? (prompt ? WS_QP : WS_QS) : (prompt ? WS_KP : WS_KS))) + ((size_t)(b * 8 + hm) * Sx + s0) * 64 + 4 * fq;
            float* dstK = out + OUT_STK + ((size_t)(b * 8 + hm) * 256) * 64 + 4 * fq;
#pragma unroll
            for (int ai = 0; ai < 2; ++ai)
#pragma unroll
                for (int m = 0; m < 4; ++m) {
                    const int rl = ai * 128 + wr * 64 + m * 16 + fr;
                    f32x4 v[2][2]; float ss = 0.f;
#pragma unroll
                    for (int bj = 0; bj < 2; ++bj)
#pragma unroll
                        for (int n = 0; n < 2; ++n) { v[bj][n] = acc[ai][bj][m][n]; const f32x4 q = v[bj][n] * v[bj][n]; ss += (q[0] + q[1]) + (q[2] + q[3]); }
                    ss += __shfl_xor(ss, 16); ss += __shfl_xor(ss, 32);
                    const float rstd = rsqrtf(ss * (1.0f / 64.0f) + 1e-6f);
#pragma unroll
                    for (int bj = 0; bj < 2; ++bj)
#pragma unroll
                        for (int n = 0; n < 2; ++n) v[bj][n] = v[bj][n] * rstd * g4[bj][n];
                    if (!prompt) {
                        const int gr = (s0 >> 6) + 2 * ai + wr, gc = 16 * m + fr;
#pragma unroll
                        for (int bj = 0; bj < 2; ++bj) {
                            const int pos = bj == 0 ? gr : gc;
                            const f32x4 c4 = *(const f32x4*)((const float*)(ws + WS_ROPEC) + pos * 16 + 4 * fq), s4 = *(const f32x4*)((const float*)(ws + WS_ROPES) + pos * 16 + 4 * fq);
                            const f32x4 a1 = v[bj][0], a2 = v[bj][1];
                            v[bj][0] = a1 * c4 - a2 * s4; v[bj][1] = a2 * c4 + a1 * s4;
                        }
                    }
#pragma unroll
                    for (int bj = 0; bj < 2; ++bj)
#pragma unroll
                        for (int n = 0; n < 2; ++n) *(u32x2*)(dst + (size_t)rl * 64 + 32 * bj + 16 * n) = pack4(v[bj][n]);
                    if (prompt && kind == 1) {
#pragma unroll
                        for (int bj = 0; bj < 2; ++bj)
#pragma unroll
                            for (int n = 0; n < 2; ++n) __builtin_nontemporal_store(v[bj][n], (f32x4*)(dstK + (size_t)rl * 64 + 32 * bj + 16 * n));
                    }
                    asm volatile("" ::: "memory");
                }
        } else if (kind == 3) {
            bf16_t* dst = (bf16_t*)(ws + WS_U) + (size_t)(pm * 256) * 512 + chw + 4 * fq;
#pragma unroll
            for (int ai = 0; ai < 2; ++ai)
#pragma unroll
                for (int m = 0; m < 4; ++m) {
                    const int rl = ai * 128 + wr * 64 + m * 16 + fr;
#pragma unroll
                    for (int bj = 0; bj < 2; ++bj)
#pragma unroll
                        for (int n = 0; n < 2; ++n) *(u32x2*)(dst + (size_t)rl * 512 + 32 * bj + 16 * n) = pack4(acc[ai][bj][m][n]);
                    asm volatile("" ::: "memory");
                }
        } else {
            const int Sx = prompt ? 256 : (kind == 2 ? 2560 : 2048);
            bf16_t* dst = (bf16_t*)(ws + (kind == 2 ? (prompt ? WS_VTP : WS_VTS) : (prompt ? WS_GVTP : WS_GVTS))) + ((size_t)b * 512 + chw) * Sx + s0;
            float* dstV = out + OUT_STV + ((size_t)(b * 4 + (chw >> 7)) * 256) * 128 + (chw & 127);
            float* dq = (float*)(ws + WS_SSQ) + (size_t)(pm * 256) * 4 + (chw >> 7);
            const unsigned lo = (unsigned)(4 * fq) * (unsigned)Sx + (unsigned)(wr * 64 + fr);
#pragma unroll
            for (int ai = 0; ai < 2; ++ai)
#pragma unroll
                for (int m = 0; m < 4; ++m) {
                    const int rl = ai * 128 + wr * 64 + m * 16 + fr;
                    float ss = 0.f;
#pragma unroll
                    for (int bj = 0; bj < 2; ++bj)
#pragma unroll
                        for (int n = 0; n < 2; ++n) {
                            const f32x4 v = acc[ai][bj][m][n]; const int co = 32 * bj + 16 * n;
                            bf16_t* dc = dst + (size_t)co * Sx + (ai * 128 + m * 16);
#pragma unroll
                            for (int j = 0; j < 4; ++j) dc[lo + (unsigned)j * (unsigned)Sx] = bf1(v[j]);
                            if (kind == 2 && prompt) __builtin_nontemporal_store(v, (f32x4*)(dstV + (size_t)rl * 128 + co + 4 * fq));
                            const f32x4 q = v * v; ss += (q[0] + q[1]) + (q[2] + q[3]);
                        }
                    if (kind == 4) {
                        ss += __shfl_xor(ss, 16); ss += __shfl_xor(ss, 32);
                        if (fq == 0) atomicAdd(dq + (size_t)rl * 4, ss);
                    }
                    asm volatile("" ::: "memory");
                }
        }
    }
};

struct EpiRes1 {
    static constexpr bool PERM = false, AFTER_DRAIN = false;
    const float *base_p, *base_s; bf16_t* out; const float* gate;
    __device__ __forceinline__ void operator()(const f32x4 (&acc)[2][2][4][2], const Unit& u, int wr, int wc, int fr, int fq) const {
        asm volatile("" : "+v"(fr), "+v"(fq));
        const int pm = u.pm, cond = pm < 32 ? 0 : 1 + ((pm - 32) >> 3);
        const float* base = pm < 32 ? base_p + (size_t)pm * 256 * 1024 : base_s + (size_t)(pm - 32) * 256 * 1024;
        bf16_t* o = out + (size_t)pm * 256 * 1024;
        const int col0 = u.pn * 256 + wc * 32 + 4 * fq;
        f32x4 gv[2][2];
#pragma unroll
        for (int bj = 0; bj < 2; ++bj)
#pragma unroll
            for (int n = 0; n < 2; ++n) gv[bj][n] = *(const f32x4*)(gate + cond * 6144 + col0 + bj * 128 + n * 16);
#pragma unroll
        for (int ai = 0; ai < 2; ++ai) {
            f32x4 bs[4][2][2];
#pragma unroll
            for (int m = 0; m < 4; ++m) { const size_t ro = (size_t)(ai * 128 + wr * 64 + m * 16 + fr) * 1024 + col0;
#pragma unroll
                for (int bj = 0; bj < 2; ++bj)
#pragma unroll
                    for (int n = 0; n < 2; ++n) bs[m][bj][n] = __builtin_nontemporal_load((const f32x4*)(base + ro + bj * 128 + n * 16)); }
            asm volatile("" ::: "memory");
#pragma unroll
            for (int m = 0; m < 4; ++m) { const size_t ro = (size_t)(ai * 128 + wr * 64 + m * 16 + fr) * 1024 + col0;
#pragma unroll
                for (int bj = 0; bj < 2; ++bj)
#pragma unroll
                    for (int n = 0; n < 2; ++n) *(u32x2*)(o + ro + bj * 128 + n * 16) = pack4(bs[m][bj][n] + gv[bj][n] * acc[ai][bj][m][n]); }
            asm volatile("" ::: "memory");
        }
    }
};
struct EpiRes2 {
    static constexpr bool PERM = false, AFTER_DRAIN = false;
    const bf16_t* base; float* out; const float* gate;
    __device__ __forceinline__ void operator()(const f32x4 (&acc)[2][2][4][2], const Unit& u, int wr, int wc, int fr, int fq) const {
        asm volatile("" : "+v"(fr), "+v"(fq));
        const int pm = u.pm, cond = pm < 32 ? 0 : 1 + ((pm - 32) >> 3);
        const bf16_t* b = base + (size_t)pm * 256 * 1024;
        float* o = out + (size_t)pm * 256 * 1024;
        const int col0 = u.pn * 256 + wc * 32 + 4 * fq;
        f32x4 gv[2][2];
#pragma unroll
        for (int bj = 0; bj < 2; ++bj)
#pragma unroll
            for (int n = 0; n < 2; ++n) gv[bj][n] = *(const f32x4*)(gate + cond * 6144 + col0 + bj * 128 + n * 16);
#pragma unroll
        for (int ai = 0; ai < 2; ++ai) {
            u32x2 bs[4][2][2];
#pragma unroll
            for (int m = 0; m < 4; ++m) { const size_t ro = (size_t)(ai * 128 + wr * 64 + m * 16 + fr) * 1024 + col0;
#pragma unroll
                for (int bj = 0; bj < 2; ++bj)
#pragma unroll
                    for (int n = 0; n < 2; ++n) bs[m][bj][n] = __builtin_nontemporal_load((const u32x2*)(b + ro + bj * 128 + n * 16)); }
            asm volatile("" ::: "memory");
#pragma unroll
            for (int m = 0; m < 4; ++m) { const size_t ro = (size_t)(ai * 128 + wr * 64 + m * 16 + fr) * 1024 + col0;
#pragma unroll
                for (int bj = 0; bj < 2; ++bj)
#pragma unroll
                    for (int n = 0; n < 2; ++n) { const u32x2 w = bs[m][bj][n];
                        const f32x4 x1 = (f32x4){__uint_as_float(w.x << 16), __uint_as_float(w.x & 0xffff0000u), __uint_as_float(w.y << 16), __uint_as_float(w.y & 0xffff0000u)};
                        __builtin_nontemporal_store(x1 + gv[bj][n] * acc[ai][bj][m][n], (f32x4*)(o + ro + bj * 128 + n * 16)); } }
            asm volatile("" ::: "memory");
        }
    }
};

struct EpiSwiglu {
    static constexpr bool PERM = false, AFTER_DRAIN = false;
    bf16_t* H;
    __device__ __forceinline__ void operator()(const f32x4 (&acc)[2][2][4][2], const Unit& u, int wr, int wc, int fr, int fq) const {
        asm volatile("" : "+v"(fr), "+v"(fq));
        bf16_t* dst = H + (size_t)(u.pm * 256) * 2816 + u.pn * 128 + wc * 32 + 4 * fq;
#pragma unroll
        for (int ai = 0; ai < 2; ++ai)
#pragma unroll
            for (int m = 0; m < 4; ++m) {
                const int rl = ai * 128 + wr * 64 + m * 16 + fr;
#pragma unroll
                for (int n = 0; n < 2; ++n) {
                    const f32x4 g = acc[ai][0][m][n], up = acc[ai][1][m][n]; f32x4 h;
#pragma unroll
                    for (int j = 0; j < 4; ++j) h[j] = g[j] * __builtin_amdgcn_rcpf(1.0f + __expf(-g[j])) * up[j];
                    *(u32x2*)(dst + (size_t)rl * 2816 + 16 * n) = pack4(h);
                }
            }
    }
};

template <class Epi, class Sched, bool ALIGN_EPI = false, bool SP2 = false>
__device__ __forceinline__ void gemm_phase(PG8_LAS unsigned char* lds, const Gemm g, const Sched& S, const Epi& E) {
    const int tid = threadIdx.x, wid = __builtin_amdgcn_readfirstlane(tid >> 6), lane = tid & 63, wr = wid >> 2, wc = wid & 3, fr = lane & 15, fq = lane >> 4;
    const int K = g.K, nt = K / BK;
    unsigned voffA[2], voffB[2];
#pragma unroll
    for (int i = 0; i < 2; ++i) { int R, C; stage_rc(tid * 16 + i * 8192, R, C); const int Rb = Epi::PERM ? ((R & ~31) + perm32(R & 31)) : R;
        voffA[i] = (unsigned)(R * K + C) * 2u; voffB[i] = (unsigned)(Rb * K + C) * 2u; }
    const size_t kstep = (size_t)(BK * 2);
    const size_t hstep = (size_t)HALF * K * 2;
    const size_t tstep = 2 * hstep;
    const unsigned ldsw = (unsigned)wid * 1024u;
    const int aoff = lds_byte(wr * 64 + fr, fq * 8), boff = lds_byte(wc * 32 + fr, fq * 8);
#define PG8_SA(b, h) (((b) * 2 + (h)) * HTB)
#define PG8_SB(b, h) ((4 + (b) * 2 + (h)) * HTB)
#define PG8_STAGE(bufoff, gbase, voff) do { _Pragma("unroll") for (int _i = 0; _i < 2; ++_i) \
        __builtin_amdgcn_global_load_lds((const unsigned*)((const char*)(gbase) + (voff)[_i]), (PG8_LAS unsigned*)(lds + (bufoff) + ldsw + _i * 8192), 16, 0, 0); } while (0)
#define PG8_LDA(dst, b, h) do { _Pragma("unroll") for (int m = 0; m < 4; ++m) _Pragma("unroll") for (int k = 0; k < 2; ++k) dst[m][k] = *(const PG8_LAS bf16x8*)(lds + PG8_SA(b, h) + aoff + m * 2048 + k * 1024); } while (0)
#define PG8_LDB(dst, b, h) do { _Pragma("unroll") for (int n = 0; n < 2; ++n) _Pragma("unroll") for (int k = 0; k < 2; ++k) dst[n][k] = *(const PG8_LAS bf16x8*)(lds + PG8_SB(b, h) + boff + n * 2048 + k * 1024); } while (0)
#define PG8_MMA(ai, bj, At, Bt) do { __builtin_amdgcn_s_setprio(1); _Pragma("unroll") for (int m = 0; m < 4; ++m) _Pragma("unroll") for (int n = 0; n < 2; ++n) _Pragma("unroll") for (int k = 0; k < 2; ++k) \
        acc[ai][bj][m][n] = __builtin_amdgcn_mfma_f32_16x16x32_bf16(Bt[n][k], At[m][k], acc[ai][bj][m][n], 0, 0, 0); __builtin_amdgcn_s_setprio(0); } while (0)
#define PG8_WAIT_V(n) asm volatile("s_waitcnt vmcnt(" #n ")" ::: "memory")
#define PG8_WAIT_L(n) asm volatile("s_waitcnt lgkmcnt(" #n ")" ::: "memory")
#define PG8_BAR __builtin_amdgcn_s_barrier()
#define PG8_SCHED __builtin_amdgcn_sched_barrier(0)
    Unit cur, nxt; int ui = 0;
    if (!S.next(0, cur)) return;
    f32x4 acc[2][2][4][2];
#pragma unroll
    for (int a = 0; a < 2; ++a)
#pragma unroll
        for (int b = 0; b < 2; ++b)
#pragma unroll
            for (int m = 0; m < 4; ++m)
#pragma unroll
                for (int n = 0; n < 2; ++n) acc[a][b][m][n] = (f32x4){0.f, 0.f, 0.f, 0.f};
    bf16x8 At[4][2], B0[2][2], B1[2][2];
    const char* cA = (const char*)g.A + (size_t)cur.pm * tstep; const char* cB = (const char*)g.Bt + (size_t)cur.pn * tstep;
    S.a_ready(cur);
    if constexpr (SP2) {
        PG8_STAGE(PG8_SB(0, 0), cB, voffB); PG8_STAGE(PG8_SB(0, 1), cB + hstep, voffB); PG8_STAGE(PG8_SA(0, 0), cA, voffA); PG8_STAGE(PG8_SA(0, 1), cA + hstep, voffA);
        if (wr == 1) PG8_BAR;
        PG8_WAIT_V(2); PG8_BAR;
        PG8_STAGE(PG8_SB(1, 0), cB + kstep, voffB); PG8_STAGE(PG8_SA(1, 0), cA + kstep, voffA); PG8_STAGE(PG8_SB(1, 1), cB + hstep + kstep, voffB);
        PG8_WAIT_V(6); PG8_BAR;
    } else {
        PG8_STAGE(PG8_SB(0, 0), cB, voffB); PG8_STAGE(PG8_SA(0, 0), cA, voffA); PG8_STAGE(PG8_SB(0, 1), cB + hstep, voffB); PG8_STAGE(PG8_SA(0, 1), cA + hstep, voffA);
        if (wr == 1) PG8_BAR;
        PG8_WAIT_V(4); PG8_BAR;
        PG8_STAGE(PG8_SB(1, 0), cB + kstep, voffB); PG8_STAGE(PG8_SA(1, 0), cA + kstep, voffA); PG8_STAGE(PG8_SB(1, 1), cB + hstep + kstep, voffB);
        PG8_WAIT_V(6); PG8_BAR;
    }
    for (;;) {
        const bool has_next = S.next(ui + 1, nxt);
        const char* nA = has_next ? (const char*)g.A + (size_t)nxt.pm * tstep : cA; const char* nB = has_next ? (const char*)g.Bt + (size_t)nxt.pn * tstep : cB;
        for (int t = 0; t < nt; t += 2) {
            const bool last = (t == nt - 2);
            const char* a1 = cA + (size_t)(t + 1) * kstep;
            const char* a2 = last ? nA : cA + (size_t)(t + 2) * kstep; const char* b2 = last ? nB : cB + (size_t)(t + 2) * kstep;
            const char* a3 = a2 + kstep; const char* b3 = b2 + kstep;
            if (last && has_next) S.a_ready(nxt);
            if constexpr (SP2) {
            PG8_LDB(B0, 0, 0); PG8_LDB(B1, 0, 1); PG8_SCHED; PG8_LDA(At, 0, 0); PG8_STAGE(PG8_SA(1, 1), a1 + hstep, voffA);
            PG8_WAIT_V(8); PG8_WAIT_L(0); PG8_BAR; PG8_MMA(0, 0, At, B0); PG8_MMA(0, 1, At, B1); PG8_BAR; PG8_SCHED;
            PG8_LDA(At, 0, 1); PG8_STAGE(PG8_SB(0, 0), b2, voffB); PG8_STAGE(PG8_SB(0, 1), b2 + hstep, voffB); PG8_STAGE(PG8_SA(0, 0), a2, voffA);
            PG8_WAIT_V(8); PG8_WAIT_L(0); PG8_BAR; PG8_MMA(1, 0, At, B0); PG8_MMA(1, 1, At, B1); PG8_BAR; PG8_SCHED;
            PG8_LDB(B0, 1, 0); PG8_LDB(B1, 1, 1); PG8_SCHED; PG8_LDA(At, 1, 0); PG8_STAGE(PG8_SA(0, 1), a2 + hstep, voffA);
            PG8_WAIT_V(8); PG8_WAIT_L(0); PG8_BAR; PG8_MMA(0, 0, At, B0); PG8_MMA(0, 1, At, B1); PG8_BAR; PG8_SCHED;
            PG8_LDA(At, 1, 1); PG8_STAGE(PG8_SB(1, 0), b3, voffB); PG8_STAGE(PG8_SB(1, 1), b3 + hstep, voffB); PG8_STAGE(PG8_SA(1, 0), a3, voffA);
            PG8_WAIT_V(8); PG8_WAIT_L(0); PG8_BAR; PG8_MMA(1, 0, At, B0); PG8_MMA(1, 1, At, B1); PG8_BAR; PG8_SCHED;
            } else {
            PG8_LDB(B0, 0, 0); PG8_SCHED; PG8_LDA(At, 0, 0); PG8_STAGE(PG8_SA(1, 1), a1 + hstep, voffA);
            PG8_WAIT_L(8); PG8_BAR; PG8_WAIT_L(0); PG8_MMA(0, 0, At, B0); PG8_BAR; PG8_SCHED;
            PG8_LDB(B1, 0, 1); PG8_STAGE(PG8_SB(0, 0), b2, voffB);
            PG8_BAR; PG8_WAIT_L(0); PG8_MMA(0, 1, At, B1); PG8_BAR;
            PG8_LDA(At, 0, 1); PG8_STAGE(PG8_SA(0, 0), a2, voffA);
            PG8_BAR; PG8_WAIT_L(0); PG8_MMA(1, 0, At, B0); PG8_BAR; PG8_SCHED;
            PG8_STAGE(PG8_SB(0, 1), b2 + hstep, voffB);
            PG8_WAIT_V(6); PG8_BAR; PG8_MMA(1, 1, At, B1); PG8_BAR;
            PG8_LDB(B0, 1, 0); PG8_SCHED; PG8_LDA(At, 1, 0); PG8_STAGE(PG8_SA(0, 1), a2 + hstep, voffA);
            PG8_WAIT_L(8); PG8_BAR; PG8_WAIT_L(0); PG8_MMA(0, 0, At, B0); PG8_BAR; PG8_SCHED;
            PG8_LDB(B1, 1, 1); PG8_STAGE(PG8_SB(1, 0), b3, voffB);
            PG8_BAR; PG8_WAIT_L(0); PG8_MMA(0, 1, At, B1); PG8_BAR;
            PG8_LDA(At, 1, 1); PG8_STAGE(PG8_SA(1, 0), a3, voffA);
            PG8_BAR; PG8_WAIT_L(0); PG8_MMA(1, 0, At, B0); PG8_BAR; PG8_SCHED;
            PG8_STAGE(PG8_SB(1, 1), b3 + hstep, voffB);
            PG8_WAIT_V(6); PG8_BAR; PG8_MMA(1, 1, At, B1); PG8_BAR;
            }
        }
        if constexpr (ALIGN_EPI) { if (wr == 0) PG8_BAR; }
        if constexpr (!Epi::AFTER_DRAIN) { E(acc, cur, wr, wc, fr, fq); S.done(cur); }
        if (!has_next) break;
#pragma unroll
        for (int a = 0; a < 2; ++a)
#pragma unroll
            for (int b = 0; b < 2; ++b)
#pragma unroll
                for (int m = 0; m < 4; ++m)
#pragma unroll
                    for (int n = 0; n < 2; ++n) acc[a][b][m][n] = (f32x4){0.f, 0.f, 0.f, 0.f};
        cur = nxt; cA = nA; cB = nB; ++ui;
        if constexpr (ALIGN_EPI) { if (wr == 1) PG8_BAR; }
    }
    PG8_WAIT_V(0);
    if constexpr (!ALIGN_EPI) { if (wr == 0) PG8_BAR; }
    PG8_BAR;
    if constexpr (Epi::AFTER_DRAIN) { E.fused(acc, cur, wr, wc, fr, fq, lds, wid, lane); S.done(cur); }
#undef PG8_SA
#undef PG8_SB
#undef PG8_STAGE
#undef PG8_LDA
#undef PG8_LDB
#undef PG8_MMA
#undef PG8_WAIT_V
#undef PG8_WAIT_L
#undef PG8_BAR
#undef PG8_SCHED
}
}

#define LAS __attribute__((address_space(3)))
typedef float f32x4 __attribute__((ext_vector_type(4)));
typedef float f32x16 __attribute__((ext_vector_type(16)));
typedef short bf16x8 __attribute__((ext_vector_type(8)));
typedef unsigned u32x4 __attribute__((ext_vector_type(4)));
typedef unsigned u32x2 __attribute__((ext_vector_type(2)));

constexpr int LDS_BYTES = 147456 + 256;
constexpr size_t WS_BAR = 900 * 1024;
constexpr int NPHASE = 8;

struct Params { const float* in[25]; float* out; unsigned char* ws; int ph_lo, ph_hi; };
typedef const __attribute__((address_space(4))) Params* KP;
__device__ __forceinline__ KP kargs() { unsigned long long k = (unsigned long long)__builtin_amdgcn_kernarg_segment_ptr(); asm volatile("" : "+s"(k)); return (KP)k; }

__device__ __forceinline__ float wave_sum(float v) {
#pragma unroll
    for (int o = 1; o < 64; o <<= 1) v += __shfl_xor(v, o);
    return v;
}
__device__ __forceinline__ unsigned pk2(float lo, float hi) { return pg8::cvt_pk_bf16(lo, hi); }

__device__ __forceinline__ void sincos_small(float x, float& s, float& c) {
    const float k = rintf(x * 0.636619772367581343f);
    float r = fmaf(-k, 1.57079601287841796875f, x);
    r = fmaf(-k, 3.1391647326017846e-7f, r);
    r = fmaf(-k, 5.3903025299577648e-15f, r);
    const float r2 = r * r;
    float sp = fmaf(r2, 2.7183114939898219064e-6f, -1.9839334836096632576e-4f); sp = fmaf(sp, r2, 8.3333293858894631756e-3f); sp = fmaf(sp, r2, -1.6666665896820998054e-1f);
    const float sn = fmaf(r * r2, sp, r);
    float cp = fmaf(r2, 2.4433157118340246e-5f, -1.3887316255899256e-3f); cp = fmaf(cp, r2, 4.1666645655422476e-2f); cp = fmaf(cp, r2, -0.5f);
    const float cs = fmaf(cp, r2, 1.0f);
    const int q = ((int)k) & 3;
    const float s0 = (q & 1) ? cs : sn, c0 = (q & 1) ? sn : cs;
    s = (q & 2) ? -s0 : s0;
    c = ((q + 1) & 2) ? -c0 : c0;
}

template <int MAP>
__device__ __forceinline__ int dest_row(int n0) {
    if (MAP == 1) { const int pn = n0 >> 8, x = n0 & 255, wc = x >> 6, bj = (x >> 5) & 1; return (pn << 8) + (bj << 7) + (wc << 5); }
    if (MAP == 2) { const int bj = n0 >= DFF ? 1 : 0, rem = n0 - bj * DFF, pn = rem >> 7, x = rem & 127; return (pn << 8) + (bj << 7) + x; }
    return n0;
}
template <int MAP>
__device__ __forceinline__ void p0_transpose_item(const float* W, int K, int N, bf16* WT, LAS float* scr, int item, int lane) {
    const int nblk = N / 32, kb = item / nblk, nb = item % nblk, k0 = 64 * kb, n0 = 32 * nb;
    float wv[32];
#pragma unroll
    for (int i = 0; i < 32; ++i) wv[i] = __builtin_nontemporal_load(W + (size_t)(k0 + 2 * i + (lane >> 5)) * N + n0 + (lane & 31));
#pragma unroll
    for (int i = 0; i < 32; ++i) scr[(2 * i + (lane >> 5)) * 33 + (lane & 31)] = wv[i];
    asm volatile("s_waitcnt lgkmcnt(0)" ::: "memory");
    const int c = lane & 7; const int dr = dest_row<MAP>(n0);
#pragma unroll
    for (int j = 0; j < 4; ++j) { const int n = (lane >> 3) + 8 * j; const LAS float* s = scr + (8 * c) * 33 + n;
        u32x4 o; o.x = pk2(s[0 * 33], s[1 * 33]); o.y = pk2(s[2 * 33], s[3 * 33]); o.z = pk2(s[4 * 33], s[5 * 33]); o.w = pk2(s[6 * 33], s[7 * 33]);
        *(u32x4*)(WT + (size_t)(dr + n) * K + k0 + 8 * c) = o; }
    asm volatile("s_waitcnt lgkmcnt(0)" ::: "memory");
}

__device__ __forceinline__ void p0_ada(KP P, LAS unsigned char* lds, int tid, int lane, int wave) {
    unsigned char* ws = P->ws;
    const int G = gridDim.x, bx = blockIdx.x;
    const int gt = bx * 512 + tid, NGT = G * 512;
    for (int i = gt; i < NTOK; i += NGT) ((f32x4*)(ws + WS_SSQ))[i] = (f32x4){0.f, 0.f, 0.f, 0.f};
    if (bx == G - 1) {
        for (int i = tid; i < 1024; i += 512) {
            const int pos = i >> 4, f = i & 15;
            const float inv = exp2f(-(float)(2 * f) * (1.0f / 32.0f) * 13.287712379549449f);
            float s, c; sincos_small((float)pos * inv, s, c);
            ((float*)(ws + WS_ROPEC))[i] = c; ((float*)(ws + WS_ROPES))[i] = s;
        }
    }
    LAS float* scond = (LAS float*)lds;
    LAS float* red = (LAS float*)(lds + 36864);
    const float* wada = P->in[8]; const float* bada = P->in[9]; float* mods = (float*)(ws + WS_MODS);
    bool have = false;
    for (int it = bx; it < 192; it += G) {
        const int n0 = it * 32, c4 = (lane & 7) * 4, rg = lane >> 3, kbase = wave * 128 + rg;
        f32x4 w[16];
#pragma unroll
        for (int i = 0; i < 16; ++i) w[i] = __builtin_nontemporal_load((const f32x4*)(wada + (size_t)(kbase + 8 * i) * 6144 + n0 + c4));
        if (!have) {
            for (int idx = tid; idx < 9216; idx += 512) { const int c = idx >> 10, k = idx & 1023; const float x = c == 0 ? P->in[5][k] : P->in[4][(c - 1) * 1024 + k]; scond[idx] = x / (1.0f + __expf(-x)); }
            have = true;
        }
        __syncthreads();
        f32x4 a[9];
#pragma unroll
        for (int c = 0; c < 9; ++c) a[c] = (f32x4){0.f, 0.f, 0.f, 0.f};
#pragma unroll
        for (int i = 0; i < 16; ++i) {
#pragma unroll
            for (int c = 0; c < 9; ++c) a[c] += w[i] * scond[c * 1024 + kbase + 8 * i]; }
#pragma unroll
        for (int c = 0; c < 9; ++c)
#pragma unroll
            for (int j = 0; j < 4; ++j) { float v = a[c][j]; v += __shfl_xor(v, 8); v += __shfl_xor(v, 16); v += __shfl_xor(v, 32); a[c][j] = v; }
        if (lane < 8) {
#pragma unroll
            for (int c = 0; c < 9; ++c) *(LAS f32x4*)(red + (wave * 9 + c) * 32 + c4) = a[c]; }
        __syncthreads();
        if (tid < 288) { const int c = tid >> 5, cl = tid & 31; float s = 0.f;
#pragma unroll
            for (int p = 0; p < 8; ++p) s += red[(p * 9 + c) * 32 + cl];
            mods[c * 6144 + n0 + cl] = s + bada[n0 + cl]; }
    }
    __syncthreads();
}

__device__ __forceinline__ void convert_job(KP P, LAS unsigned char* lds, int tid, int lane, int wave, int what, int rank, int nblk) {
    unsigned char* ws = P->ws;
    const int gt = rank * 512 + tid, NGT = nblk * 512;
    if (what & 1) {
        const float* ck = P->in[2]; bf16* Ks = (bf16*)(ws + WS_KS);
        for (int i = gt; i < 262144; i += NGT) {
            const int c = i & 7, s = (i >> 3) & 511, bhm = i >> 12;
            const f32x4 a = __builtin_nontemporal_load((const f32x4*)(ck + (size_t)i * 8)), b2 = __builtin_nontemporal_load((const f32x4*)(ck + (size_t)i * 8 + 4));
            u32x4 o; o.x = pk2(a[0], a[1]); o.y = pk2(a[2], a[3]); o.z = pk2(b2[0], b2[1]); o.w = pk2(b2[2], b2[3]);
            *(u32x4*)(Ks + ((size_t)bhm * 2560 + 2048 + s) * 64 + c * 8) = o;
        }
        const float* cv = P->in[3]; bf16* VTs = (bf16*)(ws + WS_VTS);
        for (int i = gt; i < 262144; i += NGT) {
            const int sc = ((i >> 10) & 7) * 8 + (i & 7), dv = (i >> 3) & 127, bh = i >> 13;
            const float* src = cv + ((size_t)bh * 512 + sc * 8) * 128 + dv;
            float v8[8];
#pragma unroll
            for (int j = 0; j < 8; ++j) v8[j] = __builtin_nontemporal_load(src + 128 * j);
            asm volatile("" ::: "memory");
            u32x4 o; o.x = pk2(v8[0], v8[1]); o.y = pk2(v8[2], v8[3]); o.z = pk2(v8[4], v8[5]); o.w = pk2(v8[6], v8[7]);
            *(u32x4*)(VTs + ((size_t)bh * 128 + dv) * 2560 + 2048 + sc * 8) = o;
        }
    }
    {
        LAS float* scr = (LAS float*)(lds + wave * 16384);
        const int gw = rank * 8 + wave, NGW = nblk * 8;
        const int I1 = (what & 2) ? 16 * 80 : 0, I2 = (what & 4) ? 16 * 32 : 0, I3 = (what & 8) ? 16 * 176 : 0, I4 = (what & 16) ? 44 * 32 : 0, NITEMS = I1 + I2 + I3 + I4;
        for (int it = gw; it < NITEMS; it += NGW) {
            int r = it;
            if (r < I1) { p0_transpose_item<1>(P->in[10], 1024, NIN, (bf16*)(ws + WS_W1T), scr, r, lane); continue; } r -= I1;
            if (r < I2) { p0_transpose_item<0>(P->in[22], 1024, 1024, (bf16*)(ws + WS_W2T), scr, r, lane); continue; } r -= I2;
            if (r < I3) { p0_transpose_item<2>(P->in[23], 1024, 2 * DFF, (bf16*)(ws + WS_W3T), scr, r, lane); continue; } r -= I3;
            p0_transpose_item<0>(P->in[24], DFF, 1024, (bf16*)(ws + WS_W4T), scr, r, lane);
        }
    }
}

template <bool BF>
__device__ __forceinline__ void norm_phase(const float* xp, const float* xs, const float* g, const float* mods, int shift_off, int scale_off, bf16* XM, int lane, int wave) {
    const int gw = blockIdx.x * 8 + wave, NGW = gridDim.x * 8;
    constexpr int R = 3;
    for (int m0 = gw * R; m0 < NTOK; m0 += NGW * R) {
        f32x4 v[R][4];
#pragma unroll
        for (int rr = 0; rr < R; ++rr) { const int m = m0 + rr;
            if (BF) {
                const u32x2* xr = (const u32x2*)((const bf16*)xp + (size_t)m * DM) + lane;
#pragma unroll
                for (int j = 0; j < 4; ++j) { const u32x2 w = __builtin_nontemporal_load(xr + 64 * j);
                    v[rr][j] = (f32x4){__uint_as_float(w.x << 16), __uint_as_float(w.x & 0xffff0000u), __uint_as_float(w.y << 16), __uint_as_float(w.y & 0xffff0000u)}; }
            } else {
                const float* xrow = m < NPROMPT ? xp + (size_t)m * DM : xs + (size_t)(m - NPROMPT) * DM;
                const f32x4* xr = (const f32x4*)xrow + lane;
#pragma unroll
                for (int j = 0; j < 4; ++j) v[rr][j] = __builtin_nontemporal_load(xr + 64 * j);
            } }
#pragma unroll
        for (int rr = 0; rr < R; ++rr) { const int m = m0 + rr;
            const int cond = m < NPROMPT ? 0 : 1 + ((m - NPROMPT) >> 11);
            float s = 0.f;
#pragma unroll
            for (int j = 0; j < 4; ++j) { const f32x4 q = v[rr][j] * v[rr][j]; s += (q[0] + q[1]) + (q[2] + q[3]); }
            const float rstd = rsqrtf(wave_sum(s) * (1.0f / DM) + 1e-6f);
            const float* sh = mods + cond * 6144 + shift_off; const float* sc = mods + cond * 6144 + scale_off;
            u32x2* o8 = (u32x2*)(XM + (size_t)m * DM) + lane;
#pragma unroll
            for (int j = 0; j < 4; ++j) {
                const f32x4 gg = ((const f32x4*)g)[lane + 64 * j], s1 = ((const f32x4*)sc)[lane + 64 * j], h1 = ((const f32x4*)sh)[lane + 64 * j];
                const f32x4 y = v[rr][j] * rstd * gg * (1.0f + s1) + h1;
                u32x2 w; w.x = pk2(y[0], y[1]); w.y = pk2(y[2], y[3]); o8[64 * j] = w;
            }
        }
    }
}

__device__ __forceinline__ void sgu_phase(KP P, LAS unsigned char* lds, int tid, int lane, int wave) {
    unsigned char* ws = P->ws;
    const float* ssq = (const float*)(ws + WS_SSQ);
    const bf16* U = (const bf16*)(ws + WS_U);
    bf16* MIX = (bf16*)(ws + WS_XM);
    const float* sng = P->in[18]; const float* sw = P->in[19]; const float* sb = P->in[20]; const float* mog = P->in[21];
    const int r = lane & 31, h = lane >> 5, pb = wave & 3, ch2 = wave >> 2;
    constexpr int TP = 272;
    LAS unsigned char* A = lds;
    LAS unsigned char* B = lds + 32768;
    LAS unsigned char* UT = lds + 65536;
    LAS unsigned char* OT = lds + 65536 + 128 * TP;
    LAS float* red = (LAS float*)(lds + 65536 + 256 * TP);
    LAS float* rsq = red + 256;
    LAS float* rstv = rsq + 512;
    for (int ck = blockIdx.x; ck < 192; ck += gridDim.x) {
        const bool prompt = ck < 64;
        const int b = prompt ? (ck >> 1) : ((ck - 64) >> 4), s0 = prompt ? ((ck & 1) << 7) : (((ck - 64) & 15) << 7), Sx = prompt ? 256 : 2048;
        const bf16* GVT = prompt ? (const bf16*)(ws + WS_GVTP) : (const bf16*)(ws + WS_GVTS);
        const int tok0 = ck * 128;
        __syncthreads();
        { const int q = tid >> 2, g = tid & 3; rsq[g * 128 + q] = rsqrtf(ssq[(size_t)(tok0 + q) * 4 + g] * (1.0f / 128.0f) + 1e-6f); }
        const int p = pb * 32 + r;
        float ss = 0.f;
#pragma unroll 1
        for (int g = 0; g < 4; ++g) {
            __syncthreads();
#pragma unroll
            for (int i = 0; i < 4; ++i) { const int q = tid + 512 * i, c = q >> 4, cc = q & 15;
                const u32x4 v = __builtin_nontemporal_load((const u32x4*)(GVT + ((size_t)b * 512 + g * 128 + c) * Sx + s0 + cc * 8));
                const u32x4 uu = __builtin_nontemporal_load((const u32x4*)(U + (size_t)(tok0 + c) * 512 + g * 128 + cc * 8));
                *(LAS u32x4*)(A + c * 256 + ((cc ^ (c & 15)) << 4)) = v;
                *(LAS u32x4*)(UT + c * TP + cc * 16) = uu; }
            asm volatile("" ::: "memory");
#pragma unroll
            for (int i = 0; i < 8; ++i) { const int idx = tid + 512 * i, pp = idx >> 5, q4 = (idx & 31) << 2;
                const f32x4 w = *(const f32x4*)(sw + (size_t)g * 16384 + pp * 128 + q4);
                const f32x4 rs = *(const LAS f32x4*)(rsq + g * 128 + q4);
                const f32x4 y = w * rs; u32x2 o; o.x = pk2(y[0], y[1]); o.y = pk2(y[2], y[3]);
                const int cc = q4 >> 3;
                *(LAS u32x2*)(B + pp * 256 + ((cc ^ (pp & 15)) << 4) + ((q4 & 4) << 1)) = o;
                if (i == 3) asm volatile("" ::: "memory"); }
            __syncthreads();
            f32x16 acc[2]; acc[0] = (f32x16)(0.f); acc[1] = (f32x16)(0.f);
#pragma unroll
            for (int ks = 0; ks < 8; ++ks) {
                const bf16x8 bw = *(const LAS bf16x8*)(B + p * 256 + (((2 * ks + h) ^ (p & 15)) << 4));
#pragma unroll
                for (int t = 0; t < 2; ++t) { const int crow = (ch2 * 2 + t) * 32 + r;
                    const bf16x8 ag = *(const LAS bf16x8*)(A + crow * 256 + (((2 * ks + h) ^ (crow & 15)) << 4));
                    acc[t] = __builtin_amdgcn_mfma_f32_32x32x16_bf16(ag, bw, acc[t], 0, 0, 0); }
            }
            const float bp = sb[g * 128 + p];
#pragma unroll
            for (int t = 0; t < 2; ++t)
#pragma unroll
                for (int q = 0; q < 4; ++q) {
                    const int c = (ch2 * 2 + t) * 32 + 8 * q + 4 * h;
                    const f32x4 gn = *(const f32x4*)(sng + g * 128 + c);
                    const u32x2 uu = *(const LAS u32x2*)(UT + p * TP + c * 2);
                    float uf[4]; uf[0] = __uint_as_float(uu.x << 16); uf[1] = __uint_as_float(uu.x & 0xffff0000u); uf[2] = __uint_as_float(uu.y << 16); uf[3] = __uint_as_float(uu.y & 0xffff0000u);
                    float v[4];
#pragma unroll
                    for (int j = 0; j < 4; ++j) { v[j] = uf[j] * fmaf(gn[j], acc[t][4 * q + j], bp); ss = fmaf(v[j], v[j], ss); }
                    u32x2 o; o.x = pk2(v[0], v[1]); o.y = pk2(v[2], v[3]);
                    *(LAS u32x2*)(OT + p * TP + c * 2) = o;
                }
            __syncthreads();
#pragma unroll
            for (int i = 0; i < 4; ++i) { const int q = tid + 512 * i, row = q >> 4, cc = q & 15;
                *(u32x4*)(MIX + (size_t)(tok0 + row) * 1024 + 512 + g * 128 + cc * 8) = *(const LAS u32x4*)(OT + row * TP + cc * 16); }
        }
        ss += __shfl_xor(ss, 32);
        if (h == 0) red[ch2 * 128 + p] = ss;
        __syncthreads();
        if (tid < 128) rstv[tid] = rsqrtf((red[tid] + red[128 + tid]) * (1.0f / 512.0f) + 1e-6f);
        __syncthreads();
#pragma unroll 4
        for (int i = 0; i < 16; ++i) { const int q = tid + 512 * i, row = q >> 6, cc = q & 63;
            u32x4* mp = (u32x4*)(MIX + (size_t)(tok0 + row) * 1024 + 512 + cc * 8);
            const u32x4 x = *mp; const float rs = rstv[row];
            const f32x4 m0 = *(const f32x4*)(mog + cc * 8), m1 = *(const f32x4*)(mog + cc * 8 + 4);
            u32x4 o;
            o.x = pk2(__uint_as_float(x.x << 16) * rs * m0[0], __uint_as_float(x.x & 0xffff0000u) * rs * m0[1]);
            o.y = pk2(__uint_as_float(x.y << 16) * rs * m0[2], __uint_as_float(x.y & 0xffff0000u) * rs * m0[3]);
            o.z = pk2(__uint_as_float(x.z << 16) * rs * m1[0], __uint_as_float(x.z & 0xffff0000u) * rs * m1[1]);
            o.w = pk2(__uint_as_float(x.w << 16) * rs * m1[2], __uint_as_float(x.w & 0xffff0000u) * rs * m1[3]);
            *mp = o; }
    }
    __syncthreads();
}

__device__ __forceinline__ float max3f(float a, float b, float c) { float r; asm("v_max3_f32 %0, %1, %2, %3" : "=v"(r) : "v"(a), "v"(b), "v"(c)); return r; }
__device__ __forceinline__ void attn_unit(LAS unsigned char* lds, const bf16* Qb, int Sq, int q0, const bf16* Kb, const bf16* VTb, int Sk,
                                          bf16* mixp, const float* gout, float lam, int tid, int lane, int wave, int tmul = 1) {
    const int r = lane & 31, h = lane >> 5, qsub = wave >> 1, map = wave & 1;
    const int nt = Sk >> 6;
    bf16x8 qf[4];
    { const bf16* qp = Qb + ((size_t)map * Sq + q0 + qsub * 32 + r) * 64 + 8 * h;
#pragma unroll
      for (int ks = 0; ks < 4; ++ks) qf[ks] = *(const bf16x8*)(qp + 16 * ks); }
    const bf16* K1 = Kb; const bf16* K2 = Kb + (size_t)Sk * 64;
    const int srow = tid >> 3, sc = tid & 7;
    const int so = srow * 128 + ((sc ^ ((srow >> 1) & 7)) << 4);
    const bf16* gk1 = K1 + tid * 8; const bf16* gk2 = K2 + tid * 8;
    const bf16* gv0 = VTb + (size_t)srow * Sk + sc * 8; const bf16* gv1 = gv0 + (size_t)64 * Sk;
    const int kr = (r & 19) | ((r & 4) << 1) | ((r & 8) >> 1);
    const int kx = (h ^ ((kr >> 1) & 7)) << 4, koff = map * 8192 + kr * 128;
    const int vx = (h ^ ((r >> 1) & 7)) << 4, voff = 16384 + r * 128;
    f32x16 O[4];
#pragma unroll
    for (int i = 0; i < 4; ++i) O[i] = (f32x16)(0.f);
    float mrun = -1e30f, lsum = 0.f;
    const float C = 0.18033688011112042f;
    const float TLAZY = 8.0f / 0.18033688011112042f;
    u32x4 st0, st1, st2, st3;
    st0 = *(const u32x4*)gk1; st1 = *(const u32x4*)gk2; st2 = *(const u32x4*)gv0; st3 = *(const u32x4*)gv1;
    *(LAS u32x4*)(lds + so) = st0; *(LAS u32x4*)(lds + 8192 + so) = st1; *(LAS u32x4*)(lds + 16384 + so) = st2; *(LAS u32x4*)(lds + 24576 + so) = st3;
    __syncthreads();
    for (int t = 0; t < nt; ++t) {
        LAS unsigned char* buf = lds + ((t & 1) << 15);
        const bool p1 = t + 1 < nt;
        if (p1) { const int e = (t + 1) * tmul * 64;
            st0 = *(const u32x4*)(gk1 + (size_t)e * 64); st1 = *(const u32x4*)(gk2 + (size_t)e * 64); st2 = *(const u32x4*)(gv0 + e); st3 = *(const u32x4*)(gv1 + e); }
        bf16x8 fa[8], fb[8];
#pragma unroll
        for (int ks = 0; ks < 4; ++ks) { const int co = ((2 * ks) << 4) ^ kx; fa[2 * ks] = *(const LAS bf16x8*)(buf + koff + co); fa[2 * ks + 1] = *(const LAS bf16x8*)(buf + koff + 4096 + co); }
        __builtin_amdgcn_sched_barrier(0);
        f32x16 S0 = (f32x16)(0.f), S1 = (f32x16)(0.f);
#pragma unroll
        for (int ks = 0; ks < 4; ++ks) { S0 = __builtin_amdgcn_mfma_f32_32x32x16_bf16(fa[2 * ks], qf[ks], S0, 0, 0, 0); S1 = __builtin_amdgcn_mfma_f32_32x32x16_bf16(fa[2 * ks + 1], qf[ks], S1, 0, 0, 0); }
#pragma unroll
        for (int kk = 0; kk < 2; ++kk) { const int co = ((2 * kk) << 4) ^ vx;
#pragma unroll
            for (int d = 0; d < 4; ++d) fb[kk * 4 + d] = *(const LAS bf16x8*)(buf + voff + d * 4096 + co); }
        __builtin_amdgcn_sched_barrier(0);
        float mx; { float m0 = max3f(S0[0], S0[1], S0[2]), m1 = max3f(S0[3], S0[4], S0[5]), m2 = max3f(S0[6], S0[7], S0[8]), m3 = max3f(S0[9], S0[10], S0[11]);
            float m4 = max3f(S0[12], S0[13], S0[14]), m5 = max3f(S0[15], S1[0], S1[1]), m6 = max3f(S1[2], S1[3], S1[4]), m7 = max3f(S1[5], S1[6], S1[7]);
            float m8 = max3f(S1[8], S1[9], S1[10]), m9 = max3f(S1[11], S1[12], S1[13]), m10 = max3f(S1[14], S1[15], m0);
            m1 = max3f(m1, m2, m3); m4 = max3f(m4, m5, m6); m7 = max3f(m7, m8, m9); mx = max3f(m1, m4, m7); mx = max3f(mx, m10, m10); }
        { const u32x2 sw2 = __builtin_amdgcn_permlane32_swap(__float_as_uint(mx), __float_as_uint(mx), false, false); mx = max3f(__uint_as_float(sw2.x), __uint_as_float(sw2.y), mx); }
        if (__builtin_amdgcn_ballot_w64(mx > mrun + TLAZY) != 0ull) {
            const float mnew = (mx > mrun + TLAZY) ? mx : mrun; const float alpha = __builtin_amdgcn_exp2f((mrun - mnew) * C);
            mrun = mnew; lsum *= alpha;
#pragma unroll
            for (int d = 0; d < 4; ++d) O[d] = O[d] * alpha; }
        { const float mc = mrun * C; S0 = S0 * C - mc; S1 = S1 * C - mc; }
#pragma unroll
        for (int i = 0; i < 16; ++i) { S0[i] = __builtin_amdgcn_exp2f(S0[i]); S1[i] = __builtin_amdgcn_exp2f(S1[i]); }
        { const f32x16 sv = S0 + S1;
          lsum += ((sv[0] + sv[1]) + (sv[2] + sv[3])) + ((sv[4] + sv[5]) + (sv[6] + sv[7])) + (((sv[8] + sv[9]) + (sv[10] + sv[11])) + ((sv[12] + sv[13]) + (sv[14] + sv[15]))); }
        bf16x8 pf[4];
#pragma unroll
        for (int s2 = 0; s2 < 2; ++s2) { u32x4 w0, w1;
            w0.x = pk2(S0[8 * s2 + 0], S0[8 * s2 + 1]); w0.y = pk2(S0[8 * s2 + 2], S0[8 * s2 + 3]); w0.z = pk2(S0[8 * s2 + 4], S0[8 * s2 + 5]); w0.w = pk2(S0[8 * s2 + 6], S0[8 * s2 + 7]);
            w1.x = pk2(S1[8 * s2 + 0], S1[8 * s2 + 1]); w1.y = pk2(S1[8 * s2 + 2], S1[8 * s2 + 3]); w1.z = pk2(S1[8 * s2 + 4], S1[8 * s2 + 5]); w1.w = pk2(S1[8 * s2 + 6], S1[8 * s2 + 7]);
            pf[s2] = __builtin_bit_cast(bf16x8, w0); pf[2 + s2] = __builtin_bit_cast(bf16x8, w1); }
        __builtin_amdgcn_sched_barrier(0);
#pragma unroll
        for (int kk = 2; kk < 4; ++kk) { const int co = ((2 * kk) << 4) ^ vx;
#pragma unroll
            for (int d = 0; d < 4; ++d) fa[(kk - 2) * 4 + d] = *(const LAS bf16x8*)(buf + voff + d * 4096 + co); }
        __builtin_amdgcn_sched_barrier(0);
#pragma unroll
        for (int kk = 0; kk < 2; ++kk)
#pragma unroll
            for (int d = 0; d < 4; ++d) O[d] = __builtin_amdgcn_mfma_f32_32x32x16_bf16(fb[kk * 4 + d], pf[kk], O[d], 0, 0, 0);
#pragma unroll
        for (int kk = 2; kk < 4; ++kk)
#pragma unroll
            for (int d = 0; d < 4; ++d) O[d] = __builtin_amdgcn_mfma_f32_32x32x16_bf16(fa[(kk - 2) * 4 + d], pf[kk], O[d], 0, 0, 0);
        if (p1) { LAS unsigned char* nb = lds + (((t + 1) & 1) << 15);
            *(LAS u32x4*)(nb + so) = st0; *(LAS u32x4*)(nb + 8192 + so) = st1; *(LAS u32x4*)(nb + 16384 + so) = st2; *(LAS u32x4*)(nb + 24576 + so) = st3; }
        __syncthreads();
    }
    const float l = lsum + __shfl_xor(lsum, 32);
    LAS float* comb = (LAS float*)(lds + 65536 + qsub * 16384);
    if (map == 1) {
        const float f = lam / l;
#pragma unroll
        for (int d = 0; d < 4; ++d)
#pragma unroll
            for (int i = 0; i < 16; ++i) comb[(d * 16 + i) * 64 + lane] = O[d][i] * f;
    }
    __syncthreads();
    if (map == 0) {
        const float inv = 1.0f / l; float ss = 0.f;
#pragma unroll
        for (int d = 0; d < 4; ++d)
#pragma unroll
            for (int i = 0; i < 16; ++i) { const float o = fmaf(O[d][i], inv, -comb[(d * 16 + i) * 64 + lane]); O[d][i] = o; ss = fmaf(o, o, ss); }
        ss += __shfl_xor(ss, 32);
        const float rs = rsqrtf(ss * (1.0f / 128.0f) + 1e-6f) * 0.8f;
        int r2 = r; asm volatile("" : "+v"(r2));
        LAS unsigned char* ot = lds + (qsub * 32 + r2) * 272;
#pragma unroll
        for (int d = 0; d < 4; ++d)
#pragma unroll
            for (int q = 0; q < 4; ++q) {
                const int dv = 32 * d + 8 * q + 4 * h;
                const f32x4 gg = *(const f32x4*)(gout + dv);
                u32x2 o; o.x = pk2(O[d][4 * q] * rs * gg[0], O[d][4 * q + 1] * rs * gg[1]); o.y = pk2(O[d][4 * q + 2] * rs * gg[2], O[d][4 * q + 3] * rs * gg[3]);
                *(LAS u32x2*)(ot + dv * 2) = o;
                if (q & 1) asm volatile("" ::: "memory");
            }
    }
    __syncthreads();
    int t2 = tid; asm volatile("" : "+v"(t2));
#pragma unroll
    for (int i = 0; i < 4; ++i) { const int q = t2 + 512 * i, row = q >> 4, cc = q & 15;
        *(u32x4*)(mixp + (size_t)row * 1024 + cc * 8) = *(const LAS u32x4*)(lds + row * 272 + cc * 16); }
    __syncthreads();
}

__device__ __forceinline__ void attn_phase(KP P, LAS unsigned char* lds, int tid, int lane, int wave, bool shadow = false, int tmul = 1) {
    unsigned char* ws = P->ws;
    const float d1 = wave_sum(P->in[13][lane] * P->in[14][lane]), d2 = wave_sum(P->in[15][lane] * P->in[16][lane]);
    const float lam = __expf(d1) - __expf(d2) + 0.2f;
    bf16* MIX = shadow ? (bf16*)(ws + 206 * MiB) : (bf16*)(ws + WS_XM);
    const float* aog = P->in[17];
    const int G = gridDim.x, bx = blockIdx.x;
    const int n_items = (G == 256) ? (bx >= 192 ? 6 : 2) : 0;
    for (int it = 0, j = bx; (G == 256) ? (it < n_items) : (j < 768); ++it, j += G) {
        int jj = j;
        if (G == 256) jj = it < 2 ? bx + 256 * it : 512 + (bx - 192) * 4 + (it - 2);
        if (jj < 512) {
            const int x = jj & 7, idx = jj >> 3, grp = x * 4 + (idx >> 4), qb = idx & 15, b = grp >> 2, hh = grp & 3;
            attn_unit(lds, (const bf16*)(ws + WS_QS) + (size_t)(b * 4 + hh) * 2 * 2048 * 64, 2048, qb * 128,
                      (const bf16*)(ws + WS_KS) + (size_t)(b * 4 + hh) * 2 * 2560 * 64, (const bf16*)(ws + WS_VTS) + ((size_t)b * 512 + hh * 128) * 2560, 2560,
                      MIX + ((size_t)NPROMPT + b * 2048 + qb * 128) * 1024 + hh * 128, aog + hh * 128, lam, tid, lane, wave, tmul);
        } else {
            const int k = jj - 512, grp = k >> 1, qb = k & 1, b = grp >> 2, hh = grp & 3;
            attn_unit(lds, (const bf16*)(ws + WS_QP) + (size_t)(b * 4 + hh) * 2 * 256 * 64, 256, qb * 128,
                      (const bf16*)(ws + WS_KP) + (size_t)(b * 4 + hh) * 2 * 256 * 64, (const bf16*)(ws + WS_VTP) + ((size_t)b * 512 + hh * 128) * 256, 256,
                      MIX + ((size_t)b * 256 + qb * 128) * 1024 + hh * 128, aog + hh * 128, lam, tid, lane, wave, tmul);
        }
    }
}

#define RLX_AGENT __ATOMIC_RELAXED, __HIP_MEMORY_SCOPE_AGENT
#define XB_TMO      128
#define XB_XCNT(j)  (256  + 64 * (j))
#define XB_XSUB(j)  (1280 + 64 * (j))
#define XB_XGEN(j)  (2304 + 64 * (j))
#define XB_TOP      3328
#define XB_TOPGEN   3392
#define XCD_BAR_WORDS 3456
#define XB_SPIN_CAP (1u << 18)

__device__ __forceinline__ unsigned xb_ld(unsigned* p)              { return __hip_atomic_load(p, __ATOMIC_RELAXED, __HIP_MEMORY_SCOPE_AGENT); }
__device__ __forceinline__ unsigned xb_add(unsigned* p, unsigned v) { return __hip_atomic_fetch_add(p, v, __ATOMIC_RELAXED, __HIP_MEMORY_SCOPE_AGENT); }
__device__ __forceinline__ unsigned xb_xcc_id() { return (unsigned)__builtin_amdgcn_s_getreg((3 << 11) | 20) & 0xFu; }
#define XB_SPIN(cond, bar) do { unsigned _sp = 0; while (cond) { __builtin_amdgcn_s_sleep(1); \
    if ((++_sp & 255u) == 0u) { if (xb_ld(&(bar)[XB_TMO])) break; if (_sp > XB_SPIN_CAP) { atomicAdd(&(bar)[XB_TMO], 1u); break; } } } } while (0)

struct XcdBarrier {
    unsigned* bar; unsigned x;
    volatile LAS unsigned* st;
};

__device__ __forceinline__ XcdBarrier xcd_barrier_post(unsigned* bar, volatile LAS unsigned* st) {
    XcdBarrier b; b.bar = bar; b.x = xb_xcc_id(); b.st = st;
    if (threadIdx.x == 0) (void)xb_add(&bar[XB_XCNT(b.x)], 1u);
    return b;
}
__device__ __forceinline__ void xcd_barrier_complete(unsigned* bar, unsigned x, unsigned& nloc, unsigned& nx) {
    const unsigned G = gridDim.x * gridDim.y * gridDim.z;
    unsigned sum, cnt, mine, sp = 0u;
    for (;;) {
        sum = 0u; cnt = 0u; mine = 0u;
#pragma unroll
        for (unsigned j = 0; j < 16; ++j) { const unsigned c = xb_ld(&bar[XB_XCNT(j)]); sum += c; cnt += (c > 0u) ? 1u : 0u; mine = (j == x) ? c : mine; }
        if (sum == G) break;
        __builtin_amdgcn_s_sleep(1);
        if ((++sp & 255u) == 0u) { if (xb_ld(&bar[XB_TMO])) break; if (sp > XB_SPIN_CAP) { atomicAdd(&bar[XB_TMO], 1u); break; } }
    }
    nloc = mine > 0u ? mine : 1u; nx = cnt > 0u ? cnt : 1u;
}

__device__ __forceinline__ void xcd_barrier(const XcdBarrier& b) {
    asm volatile("s_waitcnt vmcnt(0)" ::: "memory");
    __syncthreads();
    if (threadIdx.x == 0) {
        unsigned* bar = b.bar;
        __builtin_amdgcn_s_waitcnt(0);
        unsigned nloc = b.st[0], nx = b.st[1];
        if (nloc == 0u) { xcd_barrier_complete(bar, b.x, nloc, nx); b.st[0] = nloc; b.st[1] = nx; }
        const unsigned old = xb_add(&bar[XB_XSUB(b.x)], 1u);
        const unsigned gen = old / nloc;
        if (old + 1u == (gen + 1u) * nloc) {
            __builtin_amdgcn_fence(__ATOMIC_RELEASE, "agent");
            asm volatile("s_waitcnt vmcnt(0)" ::: "memory");
            const unsigned og = xb_add(&bar[XB_TOP], 1u);
            const unsigned tg = og / nx;
            if (og + 1u == (tg + 1u) * nx) xb_add(&bar[XB_TOPGEN], 1u);
            else XB_SPIN(xb_ld(&bar[XB_TOPGEN]) == tg, bar);
            __builtin_amdgcn_fence(__ATOMIC_ACQUIRE, "agent");
            xb_add(&bar[XB_XGEN(b.x)], 1u);
            asm volatile("s_waitcnt vmcnt(0)" ::: "memory");
        } else {
            XB_SPIN(xb_ld(&bar[XB_XGEN(b.x)]) == gen, bar);
            __builtin_amdgcn_fence(__ATOMIC_ACQUIRE, "agent");
            asm volatile("s_waitcnt vmcnt(0)" ::: "memory");
        }
    }
    __syncthreads();
}

__global__ void __launch_bounds__(512, 2) fwd_megakernel(Params Parg) {
    extern __shared__ __attribute__((aligned(16))) unsigned char lds_raw[];
    LAS unsigned char* lds = (LAS unsigned char*)lds_raw;
    const int tid = threadIdx.x, lane = tid & 63, wave = __builtin_amdgcn_readfirstlane(tid >> 6);
    int lo, hi; XcdBarrier xbar;
    { KP P = kargs(); lo = P->ph_lo; hi = P->ph_hi;
      volatile LAS unsigned* bst = (volatile LAS unsigned*)(lds + 147456);
      if (tid == 0) { bst[0] = 0u; bst[1] = 0u; }
      __syncthreads();
      xbar = xcd_barrier_post((unsigned*)(P->ws + WS_BAR), bst); }
#define IN(k) (lo <= (k) && (k) < hi)
#define SEAM(k) do { if (IN(k) && IN((k) + 1)) { xcd_barrier(xbar); } } while (0)
    if (hi > NPHASE + 1) cg::this_grid().sync();
    const bool defer = gridDim.x == 256;
    if (IN(0)) { KP P = kargs(); p0_ada(P, lds, tid, lane, wave); }
    if (IN(0) && defer && blockIdx.x >= 192) { KP P = kargs(); convert_job(P, lds, tid, lane, wave, 2, (int)blockIdx.x - 192, 64); }
    SEAM(0);
    if (IN(1) && !defer) { KP P = kargs(); convert_job(P, lds, tid, lane, wave, 31, (int)blockIdx.x, (int)gridDim.x); }
    if (IN(1)) { KP P = kargs(); unsigned char* ws = P->ws; norm_phase<false>(P->in[0], P->in[1], P->in[6], (const float*)(ws + WS_MODS), 0, 1024, (bf16*)(ws + WS_XM), lane, wave); }
    SEAM(1);
    if (IN(2)) {
        KP P = kargs(); unsigned char* ws = P->ws;
        pg8::Gemm g{(const bf16*)(ws + WS_XM), (const bf16*)(ws + WS_W1T), NTOK, NIN, 1024}; pg8::StaticOrder S; S.init(NTOK, NIN, (int)gridDim.x, (int)blockIdx.x);
        pg8::EpiIn E{ws, P->out, P->in[11], P->in[12]};
        pg8::gemm_phase<pg8::EpiIn, pg8::StaticOrder, true, true>(lds, g, S, E);
    }
    if (IN(2) && defer && blockIdx.x >= 192) { KP P = kargs(); convert_job(P, lds, tid, lane, wave, 1 | 4, (int)blockIdx.x - 192, 64); }
    SEAM(2);
    if (IN(3)) { KP P = kargs(); sgu_phase(P, lds, tid, lane, wave); attn_phase(P, lds, tid, lane, wave); }
    SEAM(3);
    if (IN(4)) {
        KP P = kargs(); unsigned char* ws = P->ws;
        pg8::Gemm g{(const bf16*)(ws + WS_XM), (const bf16*)(ws + WS_W2T), NTOK, 1024, 1024}; pg8::StaticOrder S; S.init(NTOK, 1024, (int)gridDim.x, (int)blockIdx.x);
        pg8::EpiRes1 E{P->in[0], P->in[1], (bf16*)(ws + WS_X1B), (const float*)(ws + WS_MODS) + 2048};
        pg8::gemm_phase<pg8::EpiRes1, pg8::StaticOrder, true, true>(lds, g, S, E);
    }
    if (IN(4) && defer && blockIdx.x >= 128) { KP P = kargs(); convert_job(P, lds, tid, lane, wave, 8 | 16, (int)blockIdx.x - 128, 128); }
    SEAM(4);
    if (IN(5)) { KP P = kargs(); unsigned char* ws = P->ws; norm_phase<true>((const float*)(ws + WS_X1B), nullptr, P->in[7], (const float*)(ws + WS_MODS), 3072, 4096, (bf16*)(ws + WS_XM), lane, wave); }
    SEAM(5);
    if (IN(6)) {
        KP P = kargs(); unsigned char* ws = P->ws;
        pg8::Gemm g{(const bf16*)(ws + WS_XM), (const bf16*)(ws + WS_W3T), NTOK, 2 * DFF, 1024}; pg8::StaticOrder S; S.init(NTOK, 2 * DFF, (int)gridDim.x, (int)blockIdx.x);
        pg8::EpiSwiglu E{(bf16*)(ws + WS_HID)};
        pg8::gemm_phase<pg8::EpiSwiglu, pg8::StaticOrder, true, true>(lds, g, S, E);
    }
    SEAM(6);
    if (IN(7)) {
        KP P = kargs(); unsigned char* ws = P->ws; float* out = P->out;
        pg8::Gemm g{(const bf16*)(ws + WS_HID), (const bf16*)(ws + WS_W4T), NTOK, 1024, DFF}; pg8::StaticOrder S; S.init(NTOK, 1024, (int)gridDim.x, (int)blockIdx.x);
        pg8::EpiRes2 E{(const bf16*)(ws + WS_X1B), out + OUT_Y, (const float*)(ws + WS_MODS) + 5120};
        pg8::gemm_phase<pg8::EpiRes2, pg8::StaticOrder, true, true>(lds, g, S, E);
    }
#undef IN
#undef SEAM
}

extern "C" void kernel_launch(void* const* d_in, const int* in_sizes, int n_in, void* d_out, int out_size, void* d_ws, size_t ws_size, hipStream_t stream) {
    static int grid = 0;
    if (grid == 0) {
        if (n_in != 25 || ws_size < WS_END) { fprintf(stderr, "kernel_launch: built for 25 inputs and >= %zu bytes of workspace; got %d, %zu\n", (size_t)WS_END, n_in, ws_size); grid = -1; return; }
        int dev = 0, cus = 0, per_cu = 0;
        if (hipGetDevice(&dev) != hipSuccess || hipDeviceGetAttribute(&cus, hipDeviceAttributeMultiprocessorCount, dev) != hipSuccess) { grid = -1; return; }
        if (hipFuncSetAttribute((const void*)fwd_megakernel, hipFuncAttributeMaxDynamicSharedMemorySize, LDS_BYTES) != hipSuccess) { fprintf(stderr, "kernel_launch: hipFuncSetAttribute failed\n"); grid = -1; return; }
        if (hipOccupancyMaxActiveBlocksPerMultiprocessor(&per_cu, (const void*)fwd_megakernel, 512, LDS_BYTES) != hipSuccess || per_cu < 1) { fprintf(stderr, "kernel_launch: occupancy query says %d\n", per_cu); per_cu = 1; }
        (void)hipGetLastError();
        grid = cus * per_cu;
    }
    if (grid < 0) return;
    if (hipMemsetAsync((char*)d_ws + WS_BAR, 0, XCD_BAR_WORDS * 4, stream) != hipSuccess) { fprintf(stderr, "kernel_launch: hipMemsetAsync failed\n"); return; }
    Params p{};
    for (int i = 0; i < 25; ++i) p.in[i] = (const float*)d_in[i];
    p.out = (float*)d_out; p.ws = (unsigned char*)d_ws;
#if MK_N_LAUNCHES == 1
    p.ph_lo = 0; p.ph_hi = NPHASE;
    void* args[] = {&p};
    hipError_t e = hipLaunchCooperativeKernel((const void*)fwd_megakernel, dim3(grid), dim3(512), args, LDS_BYTES, stream);
    if (e != hipSuccess) fprintf(stderr, "kernel_launch: cooperative launch failed: %s (grid %d)\n", hipGetErrorString(e), grid);
#else
    for (int k = 0; k < NPHASE; ++k) {
        p.ph_lo = k; p.ph_hi = k + 1;
        hipLaunchKernelGGL(fwd_megakernel, dim3(grid), dim3(512), LDS_BYTES, stream, p);
    }
#endif
}
```

```cpp
#include <hip/hip_runtime.h>
#include <hip/hip_cooperative_groups.h>
#include <cstdio>
#include <cstdint>
namespace cg = cooperative_groups;

#ifndef MK_N_LAUNCHES
#define MK_N_LAUNCHES 1
#endif

typedef unsigned short bf16;
constexpr int NTOK = 24576, NPROMPT = 8192, DM = 1024, DFF = 2816, NIN = 2560;
constexpr size_t MiB = 1u << 20;
constexpr size_t WS_MODS = 0, WS_ROPEC = 256 * 1024, WS_ROPES = 260 * 1024, WS_SSQ = 512 * 1024;
constexpr size_t WS_W1T = 1 * MiB, WS_W2T = 6 * MiB, WS_W3T = 8 * MiB, WS_W4T = 19 * MiB;
constexpr size_t WS_XM = 25 * MiB;
constexpr size_t WS_A = 73 * MiB;
constexpr size_t WS_QP = WS_A, WS_QS = WS_A + 8 * MiB, WS_KP = WS_A + 24 * MiB, WS_KS = WS_A + 32 * MiB;
constexpr size_t WS_VTP = WS_A + 52 * MiB, WS_VTS = WS_A + 60 * MiB, WS_U = WS_A + 80 * MiB, WS_GVTP = WS_A + 104 * MiB, WS_GVTS = WS_A + 112 * MiB;
constexpr size_t WS_HID = WS_XM, WS_XM2 = 157 * MiB, WS_X1B = 206 * MiB, WS_XBUF = 254 * MiB, WS_END = 255 * MiB;
static_assert(WS_GVTS + 16 * MiB <= WS_END && WS_END <= 256 * MiB, "workspace map");
constexpr size_t OUT_Y = 0, OUT_STK = (size_t)NTOK * DM, OUT_STV = OUT_STK + 4194304;

namespace pg8 {
#define PG8_LAS __attribute__((address_space(3)))
typedef unsigned short bf16_t;
typedef short bf16x8 __attribute__((ext_vector_type(8)));
typedef float f32x4 __attribute__((ext_vector_type(4)));
typedef unsigned u32x4 __attribute__((ext_vector_type(4)));
constexpr int BM = 256, BK = 64, HALF = 128, HTB = HALF * BK * 2  , STAGE_BYTES = 8 * HTB, NXCD = 8, WGM = 8;

__host__ __device__ __forceinline__ int lds_byte(int r, int c) { const int st = (r >> 4) * 2 + (c >> 5), rr = r & 15, cc = c & 31, ob = rr * 64 + cc * 2; return st * 1024 + (ob ^ (((ob >> 9) & 1) << 5)); }
__host__ __device__ __forceinline__ void stage_rc(int b, int& R, int& C) { const int st = b / 1024, sb = b % 1024, swz = sb ^ (((sb >> 9) & 1) << 5); R = (st >> 1) * 16 + swz / 64; C = (st & 1) * 32 + (swz % 64) / 2; }
__host__ __device__ __forceinline__ int perm32(int rho) { const int n = rho >> 4, i = rho & 15; return 8 * (i >> 2) + 4 * n + (i & 3); }

struct Unit { int pm, pn; };
struct Gemm { const bf16_t* A; const bf16_t* Bt; int M, N, K; };

struct StaticOrder {
    int nM, nN, nwg, G, c;
    __host__ __device__ void init(int M, int N, int G_, int c_) { nM = M / BM; nN = N / BM; nwg = nM * nN; G = G_; c = c_; }
    __host__ __device__ bool next(int i, Unit& u) const {
        const long L = (long)i * G + c; if (L >= nwg) return false;
        int wgid = (int)L; { const int q = nwg / NXCD, r = nwg % NXCD, xcd = wgid % NXCD, off = wgid / NXCD; wgid = (xcd < r ? xcd * (q + 1) : r * (q + 1) + (xcd - r) * q) + off; }
        const int nig = WGM * nN, gid = wgid / nig, fm = gid * WGM, gsz = (nM - fm) < WGM ? (nM - fm) : WGM;
        u.pm = fm + ((wgid % nig) % gsz); u.pn = (wgid % nig) / gsz; return true;
    }
    __device__ __forceinline__ void a_ready(const Unit&) const {}
    __device__ __forceinline__ void done(const Unit&) const {}
};

struct PanelOrder {
    int c;
    __host__ __device__ void init(int c_) { c = c_; }
    __host__ __device__ bool next(int i, Unit& u) const {
        const int x = c & 7, idx = c >> 3;
        if (i == 0) { u.pm = x * 8 + (idx >> 2); u.pn = idx & 3; return true; }
        if (i == 1 && c < 128) { u.pm = 64 + x * 4 + (idx >> 2); u.pn = idx & 3; return true; }
        return false;
    }
    __device__ __forceinline__ void a_ready(const Unit&) const {}
    __device__ __forceinline__ void done(const Unit&) const {}
};

__device__ __forceinline__ unsigned cvt_pk_bf16(float lo, float hi) { unsigned r; asm volatile("v_cvt_pk_bf16_f32 %0, %1, %2" : "=v"(r) : "v"(lo), "v"(hi)); return r; }
typedef float f32x2 __attribute__((ext_vector_type(2)));
typedef unsigned u32x2 __attribute__((ext_vector_type(2)));
__device__ __forceinline__ u32x2 pack4(const f32x4 v) { u32x2 w; w.x = cvt_pk_bf16(v[0], v[1]); w.y = cvt_pk_bf16(v[2], v[3]); return w; }
__device__ __forceinline__ bf16_t bf1(float v) { return (bf16_t)(cvt_pk_bf16(v, 0.f) & 0xffffu); }

struct EpiIn {
    static constexpr bool PERM = false, AFTER_DRAIN = false;
    unsigned char* ws; float* out; const float *qg, *kg;
    __device__ __forceinline__ void operator()(const f32x4 (&acc)[2][2][4][2], const Unit& u, int wr, int wc, int fr, int fq) const {
        asm volatile("" : "+v"(fr), "+v"(fq));
        const int pm = u.pm, pn = u.pn;
        const bool prompt = pm < 32;
        const int b = prompt ? pm : ((pm - 32) >> 3);
        const int s0 = prompt ? 0 : (((pm - 32) & 7) << 8);
        const int kind = pn >> 1;
        const int chw = ((pn & 1) << 8) + (wc << 6);
        if (kind <= 1) {
            const int hm = chw >> 6;
            const float* gain = kind == 0 ? qg : kg;
            f32x4 g4[2][2];
#pragma unroll
            for (int bj = 0; bj < 2; ++bj)
#pragma unroll
                for (int n = 0; n < 2; ++n) g4[bj][n] = *(const f32x4*)(gain + 32 * bj + 16 * n + 4 * fq);
            const int Sx = prompt ? 256 : (kind == 0 ? 2048 : 2560);
            bf16_t* dst = (bf16_t*)(ws + (kind == 0 ? (prompt ? WS_QP : WS_QS) : (prompt ? WS_KP : WS_KS))) + ((size_t)(b * 8 + hm) * Sx + s0) * 64 + 4 * fq;
            float* dstK = out + OUT_STK + ((size_t)(b * 8 + hm) * 256) * 64 + 4 * fq;
#pragma unroll
            for (int ai = 0; ai < 2; ++ai)
#pragma unroll
                for (int m = 0; m < 4; ++m) {
                    const int rl = ai * 128 + wr * 64 + m * 16 + fr;
                    f32x4 v[2][2]; float ss = 0.f;
#pragma unroll
                    for (int bj = 0; bj < 2; ++bj)
#pragma unroll
                        for (int n = 0; n < 2; ++n) { v[bj][n] = acc[ai][bj][m][n]; const f32x4 q = v[bj][n] * v[bj][n]; ss += (q[0] + q[1]) + (q[2] + q[3]); }
                    ss += __shfl_xor(ss, 16); ss += __shfl_xor(ss, 32);
                    const float rstd = rsqrtf(ss * (1.0f / 64.0f) + 1e-6f);
#pragma unroll
                    for (int bj = 0; bj < 2; ++bj)
#pragma unroll
                        for (int n = 0; n < 2; ++n) v[bj][n] = v[bj][n] * rstd * g4[bj][n];
                    if (!prompt) {
                        const int gr = (s0 >> 6) + 2 * ai + wr, gc = 16 * m + fr;
#pragma unroll
                        for (int bj = 0; bj < 2; ++bj) {
                            const int pos = bj == 0 ? gr : gc;
                            const f32x4 c4 = *(const f32x4*)((const float*)(ws + WS_ROPEC) + pos * 16 + 4 * fq), s4 = *(const f32x4*)((const float*)(ws + WS_ROPES) + pos * 16 + 4 * fq);
                            const f32x4 a1 = v[bj][0], a2 = v[bj][1];
                            v[bj][0] = a1 * c4 - a2 * s4; v[bj][1] = a2 * c4 + a1 * s4;
                        }
                    }
#pragma unroll
                    for (int bj = 0; bj < 2; ++bj)
#pragma unroll
                        for (int n = 0; n < 2; ++n) *(u32x2*)(dst + (size_t)rl * 64 + 32 * bj + 16 * n) = pack4(v[bj][n]);
                    if (prompt && kind == 1) {
#pragma unroll
                        for (int bj = 0; bj < 2; ++bj)
#pragma unroll
                            for (int n = 0; n < 2; ++n) __builtin_nontemporal_store(v[bj][n], (f32x4*)(dstK + (size_t)rl * 64 + 32 * bj + 16 * n));
                    }
                    asm volatile("" ::: "memory");
                }
        } else if (kind == 3) {
            bf16_t* dst = (bf16_t*)(ws + WS_U) + (size_t)(pm * 256) * 512 + chw + 4 * fq;
#pragma unroll
            for (int ai = 0; ai < 2; ++ai)
#pragma unroll
                for (int m = 0; m < 4; ++m) {
                    const int rl = ai * 128 + wr * 64 + m * 16 + fr;
#pragma unroll
                    for (int bj = 0; bj < 2; ++bj)
#pragma unroll
                        for (int n = 0; n < 2; ++n) *(u32x2*)(dst + (size_t)rl * 512 + 32 * bj + 16 * n) = pack4(acc[ai][bj][m][n]);
                    asm volatile("" ::: "memory");
                }
        } else {
            const int Sx = prompt ? 256 : (kind == 2 ? 2560 : 2048);
            bf16_t* dst = (bf16_t*)(ws + (kind == 2 ? (prompt ? WS_VTP : WS_VTS) : (prompt ? WS_GVTP : WS_GVTS))) + ((size_t)b * 512 + chw) * Sx + s0;
            float* dstV = out + OUT_STV + ((size_t)(b * 4 + (chw >> 7)) * 256) * 128 + (chw & 127);
            float* dq = (float*)(ws + WS_SSQ) + (size_t)(pm * 256) * 4 + (chw >> 7);
            const unsigned lo = (unsigned)(4 * fq) * (unsigned)Sx + (unsigned)(wr * 64 + fr);
#pragma unroll
            for (int ai = 0; ai < 2; ++ai)
#pragma unroll
                for (int m = 0; m < 4; ++m) {
                    const int rl = ai * 128 + wr * 64 + m * 16 + fr;
                    float ss = 0.f;
#pragma unroll
                    for (int bj = 0; bj < 2; ++bj)
#pragma unroll
                        for (int n = 0; n < 2; ++n) {
                            const f32x4 v = acc[ai][bj][m][n]; const int co = 32 * bj + 16 * n;
                            bf16_t* dc = dst + (size_t)co * Sx + (ai * 128 + m * 16);
#pragma unroll
                            for (int j = 0; j < 4; ++j) dc[lo + (unsigned)j * (unsigned)Sx] = bf1(v[j]);
                            if (kind == 2 && prompt) __builtin_nontemporal_store(v, (f32x4*)(dstV + (size_t)rl * 128 + co + 4 * fq));
                            const f32x4 q = v * v; ss += (q[0] + q[1]) + (q[2] + q[3]);
                        }
                    if (kind == 4) {
                        ss += __shfl_xor(ss, 16); ss += __shfl_xor(ss, 32);
                        if (fq == 0) atomicAdd(dq + (size_t)rl * 4, ss);
                    }
                    asm volatile("" ::: "memory");
                }
        }
    }
};

struct EpiRes1 {
    static constexpr bool PERM = false, AFTER_DRAIN = false;
    const float *base_p, *base_s; bf16_t* out; const float* gate;
    __device__ __forceinline__ void operator()(const f32x4 (&acc)[2][2][4][2], const Unit& u, int wr, int wc, int fr, int fq) const {
        asm volatile("" : "+v"(fr), "+v"(fq));
        const int pm = u.pm, cond = pm < 32 ? 0 : 1 + ((pm - 32) >> 3);
        const float* base = pm < 32 ? base_p + (size_t)pm * 256 * 1024 : base_s + (size_t)(pm - 32) * 256 * 1024;
        bf16_t* o = out + (size_t)pm * 256 * 1024;
        const int col0 = u.pn * 256 + wc * 32 + 4 * fq;
        f32x4 gv[2][2];
#pragma unroll
        for (int bj = 0; bj < 2; ++bj)
#pragma unroll
            for (int n = 0; n < 2; ++n) gv[bj][n] = *(const f32x4*)(gate + cond * 6144 + col0 + bj * 128 + n * 16);
#pragma unroll
        for (int ai = 0; ai < 2; ++ai) {
            f32x4 bs[4][2][2];
#pragma unroll
            for (int m = 0; m < 4; ++m) { const size_t ro = (size_t)(ai * 128 + wr * 64 + m * 16 + fr) * 1024 + col0;
#pragma unroll
                for (int bj = 0; bj < 2; ++bj)
#pragma unroll
                    for (int n = 0; n < 2; ++n) bs[m][bj][n] = __builtin_nontemporal_load((const f32x4*)(base + ro + bj * 128 + n * 16)); }
            asm volatile("" ::: "memory");
#pragma unroll
            for (int m = 0; m < 4; ++m) { const size_t ro = (size_t)(ai * 128 + wr * 64 + m * 16 + fr) * 1024 + col0;
#pragma unroll
                for (int bj = 0; bj < 2; ++bj)
#pragma unroll
                    for (int n = 0; n < 2; ++n) *(u32x2*)(o + ro + bj * 128 + n * 16) = pack4(bs[m][bj][n] + gv[bj][n] * acc[ai][bj][m][n]); }
            asm volatile("" ::: "memory");
        }
    }
};
struct EpiRes1N {
    static constexpr bool PERM = false, AFTER_DRAIN = false;
    const float *base_p, *base_s; bf16_t* x1b; bf16_t* xm; const float* mods; const float* g2; float* xbuf; unsigned* cnt; PG8_LAS unsigned char* xl;
    __device__ __forceinline__ void operator()(f32x4 (&acc)[2][2][4][2], const Unit& u, int wr, int wc, int fr, int fq) const {
        asm volatile("" : "+v"(fr), "+v"(fq));
        const int pm = u.pm, pn = u.pn, cond = pm < 32 ? 0 : 1 + ((pm - 32) >> 3);
        const float* base = pm < 32 ? base_p + (size_t)pm * 256 * 1024 : base_s + (size_t)(pm - 32) * 256 * 1024;
        const int col0 = pn * 256 + wc * 32 + 4 * fq;
        const float* md = mods + cond * 6144;
        PG8_LAS float* Pt = (PG8_LAS float*)xl;
        PG8_LAS float* St = Pt + 1024;
        const int wid = wr * 4 + wc, lane = fq * 16 + fr;
        {
            f32x4 gv[2][2];
#pragma unroll
            for (int bj = 0; bj < 2; ++bj)
#pragma unroll
                for (int n = 0; n < 2; ++n) gv[bj][n] = *(const f32x4*)(md + 2048 + col0 + bj * 128 + n * 16);
#pragma unroll
            for (int am = 0; am < 4; ++am) {
                const int ai = am >> 1, m0 = (am & 1) * 2;
                f32x4 bs[2][2][2];
#pragma unroll
                for (int mm = 0; mm < 2; ++mm) { const size_t ro = (size_t)(ai * 128 + wr * 64 + (m0 + mm) * 16 + fr) * 1024 + col0;
#pragma unroll
                    for (int bj = 0; bj < 2; ++bj)
#pragma unroll
                        for (int n = 0; n < 2; ++n) bs[mm][bj][n] = __builtin_nontemporal_load((const f32x4*)(base + ro + bj * 128 + n * 16)); }
                asm volatile("" ::: "memory");
#pragma unroll
                for (int mm = 0; mm < 2; ++mm) { const int m = m0 + mm; float s = 0.f;
#pragma unroll
                    for (int bj = 0; bj < 2; ++bj)
#pragma unroll
                        for (int n = 0; n < 2; ++n) { const f32x4 x1 = bs[mm][bj][n] + gv[bj][n] * acc[ai][bj][m][n]; acc[ai][bj][m][n] = x1; const f32x4 q = x1 * x1; s += (q[0] + q[1]) + (q[2] + q[3]); }
                    s += __shfl_xor(s, 16); s += __shfl_xor(s, 32);
                    if (fq == 0) Pt[(ai * 128 + wr * 64 + m * 16 + fr) * 4 + wc] = s; }
                asm volatile("" ::: "memory");
            }
        }
        asm volatile("s_waitcnt lgkmcnt(0)" ::: "memory"); __builtin_amdgcn_s_barrier(); asm volatile("" ::: "memory");
        const int row = wid * 32 + (lane & 31);
        if (lane < 32) { const f32x4 p = *(const PG8_LAS f32x4*)(Pt + row * 4);
            __hip_atomic_store(xbuf + ((size_t)pm * 256 + row) * 4 + pn, (p[0] + p[1]) + (p[2] + p[3]), __ATOMIC_RELAXED, __HIP_MEMORY_SCOPE_AGENT); }
        asm volatile("s_waitcnt vmcnt(0)" ::: "memory");
        if (lane == 0) __hip_atomic_fetch_add(cnt + 64 * pm, 1u, __ATOMIC_RELAXED, __HIP_MEMORY_SCOPE_AGENT);
        if (wid == 0) {
            for (unsigned spins = 0; spins < (1u << 21); ++spins) {
                if ((unsigned)__builtin_amdgcn_readfirstlane(__hip_atomic_load(cnt + 64 * pm, __ATOMIC_RELAXED, __HIP_MEMORY_SCOPE_AGENT)) >= 32u) break;
                __builtin_amdgcn_s_sleep(2);
            }
            __builtin_amdgcn_fence(__ATOMIC_ACQUIRE, "agent");
        }
        asm volatile("s_waitcnt vmcnt(0) lgkmcnt(0)" ::: "memory"); __builtin_amdgcn_s_barrier(); asm volatile("" ::: "memory");
        if (lane < 32) { const float* sl = xbuf + ((size_t)pm * 256 + row) * 4; float t = 0.f;
#pragma unroll
            for (int k = 0; k < 4; ++k) t += __hip_atomic_load(sl + k, __ATOMIC_RELAXED, __HIP_MEMORY_SCOPE_AGENT);
            St[row] = rsqrtf(t * (1.0f / 1024.0f) + 1e-6f); }
        asm volatile("s_waitcnt vmcnt(0) lgkmcnt(0)" ::: "memory"); __builtin_amdgcn_s_barrier(); asm volatile("" ::: "memory");
        bf16_t* o1 = x1b + (size_t)pm * 256 * 1024; bf16_t* o2 = xm + (size_t)pm * 256 * 1024;
#pragma unroll
        for (int bj = 0; bj < 2; ++bj)
#pragma unroll
            for (int n = 0; n < 2; ++n) { const int cc = col0 + bj * 128 + n * 16;
                const f32x4 gg = *(const f32x4*)(g2 + cc), sc = *(const f32x4*)(md + 4096 + cc), sh = *(const f32x4*)(md + 3072 + cc);
                const f32x4 gs = gg * (1.0f + sc);
#pragma unroll
                for (int ai = 0; ai < 2; ++ai)
#pragma unroll
                    for (int m = 0; m < 4; ++m) { const int r = ai * 128 + wr * 64 + m * 16 + fr; const float rs = St[r]; const f32x4 x1 = acc[ai][bj][m][n];
                        *(u32x2*)(o1 + (size_t)r * 1024 + cc) = pack4(x1);
                        *(u32x2*)(o2 + (size_t)r * 1024 + cc) = pack4(x1 * rs * gs + sh); }
                asm volatile("" ::: "memory"); }
    }
};
struct EpiRes2 {
    static constexpr bool PERM = false, AFTER_DRAIN = false;
    const bf16_t* base; float* out; const float* gate;
    __device__ __forceinline__ void operator()(const f32x4 (&acc)[2][2][4][2], const Unit& u, int wr, int wc, int fr, int fq) const {
        asm volatile("" : "+v"(fr), "+v"(fq));
        const int pm = u.pm, cond = pm < 32 ? 0 : 1 + ((pm - 32) >> 3);
        const bf16_t* b = base + (size_t)pm * 256 * 1024;
        float* o = out + (size_t)pm * 256 * 1024;
        const int col0 = u.pn * 256 + wc * 32 + 4 * fq;
        f32x4 gv[2][2];
#pragma unroll
        for (int bj = 0; bj < 2; ++bj)
#pragma unroll
            for (int n = 0; n < 2; ++n) gv[bj][n] = *(const f32x4*)(gate + cond * 6144 + col0 + bj * 128 + n * 16);
#pragma unroll
        for (int ai = 0; ai < 2; ++ai) {
            u32x2 bs[4][2][2];
#pragma unroll
            for (int m = 0; m < 4; ++m) { const size_t ro = (size_t)(ai * 128 + wr * 64 + m * 16 + fr) * 1024 + col0;
#pragma unroll
                for (int bj = 0; bj < 2; ++bj)
#pragma unroll
                    for (int n = 0; n < 2; ++n) bs[m][bj][n] = __builtin_nontemporal_load((const u32x2*)(b + ro + bj * 128 + n * 16)); }
            asm volatile("" ::: "memory");
#pragma unroll
            for (int m = 0; m < 4; ++m) { const size_t ro = (size_t)(ai * 128 + wr * 64 + m * 16 + fr) * 1024 + col0;
#pragma unroll
                for (int bj = 0; bj < 2; ++bj)
#pragma unroll
                    for (int n = 0; n < 2; ++n) { const u32x2 w = bs[m][bj][n];
                        const f32x4 x1 = (f32x4){__uint_as_float(w.x << 16), __uint_as_float(w.x & 0xffff0000u), __uint_as_float(w.y << 16), __uint_as_float(w.y & 0xffff0000u)};
                        __builtin_nontemporal_store(x1 + gv[bj][n] * acc[ai][bj][m][n], (f32x4*)(o + ro + bj * 128 + n * 16)); } }
            asm volatile("" ::: "memory");
        }
    }
};

struct EpiSwiglu {
    static constexpr bool PERM = false, AFTER_DRAIN = false;
    bf16_t* H;
    __device__ __forceinline__ void operator()(const f32x4 (&acc)[2][2][4][2], const Unit& u, int wr, int wc, int fr, int fq) const {
        asm volatile("" : "+v"(fr), "+v"(fq));
        bf16_t* dst = H + (size_t)(u.pm * 256) * 2816 + u.pn * 128 + wc * 32 + 4 * fq;
#pragma unroll
        for (int ai = 0; ai < 2; ++ai)
#pragma unroll
            for (int m = 0; m < 4; ++m) {
                const int rl = ai * 128 + wr * 64 + m * 16 + fr;
#pragma unroll
                for (int n = 0; n < 2; ++n) {
                    const f32x4 g = acc[ai][0][m][n], up = acc[ai][1][m][n]; f32x4 h;
#pragma unroll
                    for (int j = 0; j < 4; ++j) h[j] = g[j] * __builtin_amdgcn_rcpf(1.0f + __expf(-g[j])) * up[j];
                    *(u32x2*)(dst + (size_t)rl * 2816 + 16 * n) = pack4(h);
                }
            }
    }
};

template <class Epi, class Sched, bool ALIGN_EPI = false, bool SP2 = false>
__device__ __forceinline__ void gemm_phase(PG8_LAS unsigned char* lds, const Gemm g, const Sched& S, const Epi& E) {
    const int tid = threadIdx.x, wid = __builtin_amdgcn_readfirstlane(tid >> 6), lane = tid & 63, wr = wid >> 2, wc = wid & 3, fr = lane & 15, fq = lane >> 4;
    const int K = g.K, nt = K / BK;
    unsigned voffA[2], voffB[2];
#pragma unroll
    for (int i = 0; i < 2; ++i) { int R, C; stage_rc(tid * 16 + i * 8192, R, C); const int Rb = Epi::PERM ? ((R & ~31) + perm32(R & 31)) : R;
        voffA[i] = (unsigned)(R * K + C) * 2u; voffB[i] = (unsigned)(Rb * K + C) * 2u; }
    const size_t kstep = (size_t)(BK * 2);
    const size_t hstep = (size_t)HALF * K * 2;
    const size_t tstep = 2 * hstep;
    const unsigned ldsw = (unsigned)wid * 1024u;
    const int aoff = lds_byte(wr * 64 + fr, fq * 8), boff = lds_byte(wc * 32 + fr, fq * 8);
#define PG8_SA(b, h) (((b) * 2 + (h)) * HTB)
#define PG8_SB(b, h) ((4 + (b) * 2 + (h)) * HTB)
#define PG8_STAGE(bufoff, gbase, voff) do { _Pragma("unroll") for (int _i = 0; _i < 2; ++_i) \
        __builtin_amdgcn_global_load_lds((const unsigned*)((const char*)(gbase) + (voff)[_i]), (PG8_LAS unsigned*)(lds + (bufoff) + ldsw + _i * 8192), 16, 0, 0); } while (0)
#define PG8_LDA(dst, b, h) do { _Pragma("unroll") for (int m = 0; m < 4; ++m) _Pragma("unroll") for (int k = 0; k < 2; ++k) dst[m][k] = *(const PG8_LAS bf16x8*)(lds + PG8_SA(b, h) + aoff + m * 2048 + k * 1024); } while (0)
#define PG8_LDB(dst, b, h) do { _Pragma("unroll") for (int n = 0; n < 2; ++n) _Pragma("unroll") for (int k = 0; k < 2; ++k) dst[n][k] = *(const PG8_LAS bf16x8*)(lds + PG8_SB(b, h) + boff + n * 2048 + k * 1024); } while (0)
#define PG8_MMA(ai, bj, At, Bt) do { __builtin_amdgcn_s_setprio(1); _Pragma("unroll") for (int m = 0; m < 4; ++m) _Pragma("unroll") for (int n = 0; n < 2; ++n) _Pragma("unroll") for (int k = 0; k < 2; ++k) \
        acc[ai][bj][m][n] = __builtin_amdgcn_mfma_f32_16x16x32_bf16(Bt[n][k], At[m][k], acc[ai][bj][m][n], 0, 0, 0); __builtin_amdgcn_s_setprio(0); } while (0)
#define PG8_WAIT_V(n) asm volatile("s_waitcnt vmcnt(" #n ")" ::: "memory")
#define PG8_WAIT_L(n) asm volatile("s_waitcnt lgkmcnt(" #n ")" ::: "memory")
#define PG8_BAR __builtin_amdgcn_s_barrier()
#define PG8_SCHED __builtin_amdgcn_sched_barrier(0)
    Unit cur, nxt; int ui = 0;
    if (!S.next(0, cur)) return;
    f32x4 acc[2][2][4][2];
#pragma unroll
    for (int a = 0; a < 2; ++a)
#pragma unroll
        for (int b = 0; b < 2; ++b)
#pragma unroll
            for (int m = 0; m < 4; ++m)
#pragma unroll
                for (int n = 0; n < 2; ++n) acc[a][b][m][n] = (f32x4){0.f, 0.f, 0.f, 0.f};
    bf16x8 At[4][2], B0[2][2], B1[2][2];
    const char* cA = (const char*)g.A + (size_t)cur.pm * tstep; const char* cB = (const char*)g.Bt + (size_t)cur.pn * tstep;
    S.a_ready(cur);
    if constexpr (SP2) {
        PG8_STAGE(PG8_SB(0, 0), cB, voffB); PG8_STAGE(PG8_SB(0, 1), cB + hstep, voffB); PG8_STAGE(PG8_SA(0, 0), cA, voffA); PG8_STAGE(PG8_SA(0, 1), cA + hstep, voffA);
        if (wr == 1) PG8_BAR;
        PG8_WAIT_V(2); PG8_BAR;
        PG8_STAGE(PG8_SB(1, 0), cB + kstep, voffB); PG8_STAGE(PG8_SA(1, 0), cA + kstep, voffA); PG8_STAGE(PG8_SB(1, 1), cB + hstep + kstep, voffB);
        PG8_WAIT_V(6); PG8_BAR;
    } else {
        PG8_STAGE(PG8_SB(0, 0), cB, voffB); PG8_STAGE(PG8_SA(0, 0), cA, voffA); PG8_STAGE(PG8_SB(0, 1), cB + hstep, voffB); PG8_STAGE(PG8_SA(0, 1), cA + hstep, voffA);
        if (wr == 1) PG8_BAR;
        PG8_WAIT_V(4); PG8_BAR;
        PG8_STAGE(PG8_SB(1, 0), cB + kstep, voffB); PG8_STAGE(PG8_SA(1, 0), cA + kstep, voffA); PG8_STAGE(PG8_SB(1, 1), cB + hstep + kstep, voffB);
        PG8_WAIT_V(6); PG8_BAR;
    }
    for (;;) {
        const bool has_next = S.next(ui + 1, nxt);
        const char* nA = has_next ? (const char*)g.A + (size_t)nxt.pm * tstep : cA; const char* nB = has_next ? (const char*)g.Bt + (size_t)nxt.pn * tstep : cB;
        for (int t = 0; t < nt; t += 2) {
            const bool last = (t == nt - 2);
            const char* a1 = cA + (size_t)(t + 1) * kstep;
            const char* a2 = last ? nA : cA + (size_t)(t + 2) * kstep; const char* b2 = last ? nB : cB + (size_t)(t + 2) * kstep;
            const char* a3 = a2 + kstep; const char* b3 = b2 + kstep;
            if (last && has_next) S.a_ready(nxt);
            if constexpr (SP2) {
            PG8_LDB(B0, 0, 0); PG8_LDB(B1, 0, 1); PG8_SCHED; PG8_LDA(At, 0, 0); PG8_STAGE(PG8_SA(1, 1), a1 + hstep, voffA);
            PG8_WAIT_V(8); PG8_WAIT_L(0); PG8_BAR; PG8_MMA(0, 0, At, B0); PG8_MMA(0, 1, At, B1); PG8_BAR; PG8_SCHED;
            PG8_LDA(At, 0, 1); PG8_STAGE(PG8_SB(0, 0), b2, voffB); PG8_STAGE(PG8_SB(0, 1), b2 + hstep, voffB); PG8_STAGE(PG8_SA(0, 0), a2, voffA);
            PG8_WAIT_V(8); PG8_WAIT_L(0); PG8_BAR; PG8_MMA(1, 0, At, B0); PG8_MMA(1, 1, At, B1); PG8_BAR; PG8_SCHED;
            PG8_LDB(B0, 1, 0); PG8_LDB(B1, 1, 1); PG8_SCHED; PG8_LDA(At, 1, 0); PG8_STAGE(PG8_SA(0, 1), a2 + hstep, voffA);
            PG8_WAIT_V(8); PG8_WAIT_L(0); PG8_BAR; PG8_MMA(0, 0, At, B0); PG8_MMA(0, 1, At, B1); PG8_BAR; PG8_SCHED;
            PG8_LDA(At, 1, 1); PG8_STAGE(PG8_SB(1, 0), b3, voffB); PG8_STAGE(PG8_SB(1, 1), b3 + hstep, voffB); PG8_STAGE(PG8_SA(1, 0), a3, voffA);
            PG8_WAIT_V(8); PG8_WAIT_L(0); PG8_BAR; PG8_MMA(1, 0, At, B0); PG8_MMA(1, 1, At, B1); PG8_BAR; PG8_SCHED;
            } else {
            PG8_LDB(B0, 0, 0); PG8_SCHED; PG8_LDA(At, 0, 0); PG8_STAGE(PG8_SA(1, 1), a1 + hstep, voffA);
            PG8_WAIT_L(8); PG8_BAR; PG8_WAIT_L(0); PG8_MMA(0, 0, At, B0); PG8_BAR; PG8_SCHED;
            PG8_LDB(B1, 0, 1); PG8_STAGE(PG8_SB(0, 0), b2, voffB);
            PG8_BAR; PG8_WAIT_L(0); PG8_MMA(0, 1, At, B1); PG8_BAR;
            PG8_LDA(At, 0, 1); PG8_STAGE(PG8_SA(0, 0), a2, voffA);
            PG8_BAR; PG8_WAIT_L(0); PG8_MMA(1, 0, At, B0); PG8_BAR; PG8_SCHED;
            PG8_STAGE(PG8_SB(0, 1), b2 + hstep, voffB);
            PG8_WAIT_V(6); PG8_BAR; PG8_MMA(1, 1, At, B1); PG8_BAR;
            PG8_LDB(B0, 1, 0); PG8_SCHED; PG8_LDA(At, 1, 0); PG8_STAGE(PG8_SA(0, 1), a2 + hstep, voffA);
            PG8_WAIT_L(8); PG8_BAR; PG8_WAIT_L(0); PG8_MMA(0, 0, At, B0); PG8_BAR; PG8_SCHED;
            PG8_LDB(B1, 1, 1); PG8_STAGE(PG8_SB(1, 0), b3, voffB);
            PG8_BAR; PG8_WAIT_L(0); PG8_MMA(0, 1, At, B1); PG8_BAR;
            PG8_LDA(At, 1, 1); PG8_STAGE(PG8_SA(1, 0), a3, voffA);
            PG8_BAR; PG8_WAIT_L(0); PG8_MMA(1, 0, At, B0); PG8_BAR; PG8_SCHED;
            PG8_STAGE(PG8_SB(1, 1), b3 + hstep, voffB);
            PG8_WAIT_V(6); PG8_BAR; PG8_MMA(1, 1, At, B1); PG8_BAR;
            }
        }
        if constexpr (ALIGN_EPI) { if (wr == 0) PG8_BAR; }
        if constexpr (!Epi::AFTER_DRAIN) { E(acc, cur, wr, wc, fr, fq); S.done(cur); }
        if (!has_next) break;
#pragma unroll
        for (int a = 0; a < 2; ++a)
#pragma unroll
            for (int b = 0; b < 2; ++b)
#pragma unroll
                for (int m = 0; m < 4; ++m)
#pragma unroll
                    for (int n = 0; n < 2; ++n) acc[a][b][m][n] = (f32x4){0.f, 0.f, 0.f, 0.f};
        cur = nxt; cA = nA; cB = nB; ++ui;
        if constexpr (ALIGN_EPI) { if (wr == 1) PG8_BAR; }
    }
    PG8_WAIT_V(0);
    if constexpr (!ALIGN_EPI) { if (wr == 0) PG8_BAR; }
    PG8_BAR;
    if constexpr (Epi::AFTER_DRAIN) { E.fused(acc, cur, wr, wc, fr, fq, lds, wid, lane); S.done(cur); }
#undef PG8_SA
#undef PG8_SB
#undef PG8_STAGE
#undef PG8_LDA
#undef PG8_LDB
#undef PG8_MMA
#undef PG8_WAIT_V
#undef PG8_WAIT_L
#undef PG8_BAR
#undef PG8_SCHED
}
}

#define LAS __attribute__((address_space(3)))
typedef float f32x4 __attribute__((ext_vector_type(4)));
typedef float f32x16 __attribute__((ext_vector_type(16)));
typedef short bf16x8 __attribute__((ext_vector_type(8)));
typedef unsigned u32x4 __attribute__((ext_vector_type(4)));
typedef unsigned u32x2 __attribute__((ext_vector_type(2)));

constexpr int LDS_BYTES = 147456 + 256;
constexpr size_t WS_CNT = 916 * 1024;
constexpr size_t WS_BAR = 900 * 1024;
constexpr int NPHASE = 8;

struct Params { const float* in[25]; float* out; unsigned char* ws; int ph_lo, ph_hi; };
typedef const __attribute__((address_space(4))) Params* KP;
__device__ __forceinline__ KP kargs() { unsigned long long k = (unsigned long long)__builtin_amdgcn_kernarg_segment_ptr(); asm volatile("" : "+s"(k)); return (KP)k; }

__device__ __forceinline__ float wave_sum(float v) {
#pragma unroll
    for (int o = 1; o < 64; o <<= 1) v += __shfl_xor(v, o);
    return v;
}
__device__ __forceinline__ unsigned pk2(float lo, float hi) { return pg8::cvt_pk_bf16(lo, hi); }

__device__ __forceinline__ void sincos_small(float x, float& s, float& c) {
    const float k = rintf(x * 0.636619772367581343f);
    float r = fmaf(-k, 1.57079601287841796875f, x);
    r = fmaf(-k, 3.1391647326017846e-7f, r);
    r = fmaf(-k, 5.3903025299577648e-15f, r);
    const float r2 = r * r;
    float sp = fmaf(r2, 2.7183114939898219064e-6f, -1.9839334836096632576e-4f); sp = fmaf(sp, r2, 8.3333293858894631756e-3f); sp = fmaf(sp, r2, -1.6666665896820998054e-1f);
    const float sn = fmaf(r * r2, sp, r);
    float cp = fmaf(r2, 2.4433157118340246e-5f, -1.3887316255899256e-3f); cp = fmaf(cp, r2, 4.1666645655422476e-2f); cp = fmaf(cp, r2, -0.5f);
    const float cs = fmaf(cp, r2, 1.0f);
    const int q = ((int)k) & 3;
    const float s0 = (q & 1) ? cs : sn, c0 = (q & 1) ? sn : cs;
    s = (q & 2) ? -s0 : s0;
    c = ((q + 1) & 2) ? -c0 : c0;
}

template <int MAP>
__device__ __forceinline__ int dest_row(int n0) {
    if (MAP == 1) { const int pn = n0 >> 8, x = n0 & 255, wc = x >> 6, bj = (x >> 5) & 1; return (pn << 8) + (bj << 7) + (wc << 5); }
    if (MAP == 2) { const int bj = n0 >= DFF ? 1 : 0, rem = n0 - bj * DFF, pn = rem >> 7, x = rem & 127; return (pn << 8) + (bj << 7) + x; }
    return n0;
}
template <int MAP>
__device__ __forceinline__ void p0_transpose_item(const float* W, int K, int N, bf16* WT, LAS float* scr, int item, int lane) {
    const int nblk = N / 32, kb = item / nblk, nb = item % nblk, k0 = 64 * kb, n0 = 32 * nb;
    float wv[32];
#pragma unroll
    for (int i = 0; i < 32; ++i) wv[i] = __builtin_nontemporal_load(W + (size_t)(k0 + 2 * i + (lane >> 5)) * N + n0 + (lane & 31));
#pragma unroll
    for (int i = 0; i < 32; ++i) scr[(2 * i + (lane >> 5)) * 33 + (lane & 31)] = wv[i];
    asm volatile("s_waitcnt lgkmcnt(0)" ::: "memory");
    const int c = lane & 7; const int dr = dest_row<MAP>(n0);
#pragma unroll
    for (int j = 0; j < 4; ++j) { const int n = (lane >> 3) + 8 * j; const LAS float* s = scr + (8 * c) * 33 + n;
        u32x4 o; o.x = pk2(s[0 * 33], s[1 * 33]); o.y = pk2(s[2 * 33], s[3 * 33]); o.z = pk2(s[4 * 33], s[5 * 33]); o.w = pk2(s[6 * 33], s[7 * 33]);
        *(u32x4*)(WT + (size_t)(dr + n) * K + k0 + 8 * c) = o; }
    asm volatile("s_waitcnt lgkmcnt(0)" ::: "memory");
}

__device__ __forceinline__ void p0_ada(KP P, LAS unsigned char* lds, int tid, int lane, int wave) {
    unsigned char* ws = P->ws;
    const int G = gridDim.x, bx = blockIdx.x;
    const int gt = bx * 512 + tid, NGT = G * 512;
    for (int i = gt; i < NTOK; i += NGT) ((f32x4*)(ws + WS_SSQ))[i] = (f32x4){0.f, 0.f, 0.f, 0.f};
    if (bx == G - 1) {
        for (int i = tid; i < 1024; i += 512) {
            const int pos = i >> 4, f = i & 15;
            const float inv = exp2f(-(float)(2 * f) * (1.0f / 32.0f) * 13.287712379549449f);
            float s, c; sincos_small((float)pos * inv, s, c);
            ((float*)(ws + WS_ROPEC))[i] = c; ((float*)(ws + WS_ROPES))[i] = s;
        }
    }
    LAS float* scond = (LAS float*)lds;
    LAS float* red = (LAS float*)(lds + 36864);
    const float* wada = P->in[8]; const float* bada = P->in[9]; float* mods = (float*)(ws + WS_MODS);
    bool have = false;
    for (int it = bx; it < 192; it += G) {
        const int n0 = it * 32, c4 = (lane & 7) * 4, rg = lane >> 3, kbase = wave * 128 + rg;
        f32x4 w[16];
#pragma unroll
        for (int i = 0; i < 16; ++i) w[i] = __builtin_nontemporal_load((const f32x4*)(wada + (size_t)(kbase + 8 * i) * 6144 + n0 + c4));
        if (!have) {
            for (int idx = tid; idx < 9216; idx += 512) { const int c = idx >> 10, k = idx & 1023; const float x = c == 0 ? P->in[5][k] : P->in[4][(c - 1) * 1024 + k]; scond[idx] = x / (1.0f + __expf(-x)); }
            have = true;
        }
        __syncthreads();
        f32x4 a[9];
#pragma unroll
        for (int c = 0; c < 9; ++c) a[c] = (f32x4){0.f, 0.f, 0.f, 0.f};
#pragma unroll
        for (int i = 0; i < 16; ++i) {
#pragma unroll
            for (int c = 0; c < 9; ++c) a[c] += w[i] * scond[c * 1024 + kbase + 8 * i]; }
#pragma unroll
        for (int c = 0; c < 9; ++c)
#pragma unroll
            for (int j = 0; j < 4; ++j) { float v = a[c][j]; v += __shfl_xor(v, 8); v += __shfl_xor(v, 16); v += __shfl_xor(v, 32); a[c][j] = v; }
        if (lane < 8) {
#pragma unroll
            for (int c = 0; c < 9; ++c) *(LAS f32x4*)(red + (wave * 9 + c) * 32 + c4) = a[c]; }
        __syncthreads();
        if (tid < 288) { const int c = tid >> 5, cl = tid & 31; float s = 0.f;
#pragma unroll
            for (int p = 0; p < 8; ++p) s += red[(p * 9 + c) * 32 + cl];
            mods[c * 6144 + n0 + cl] = s + bada[n0 + cl]; }
    }
    __syncthreads();
}

__device__ __forceinline__ void convert_job(KP P, LAS unsigned char* lds, int tid, int lane, int wave, int what, int rank, int nblk) {
    unsigned char* ws = P->ws;
    const int gt = rank * 512 + tid, NGT = nblk * 512;
    if (what & 1) {
        const float* ck = P->in[2]; bf16* Ks = (bf16*)(ws + WS_KS);
        for (int i = gt; i < 262144; i += NGT) {
            const int c = i & 7, s = (i >> 3) & 511, bhm = i >> 12;
            const f32x4 a = __builtin_nontemporal_load((const f32x4*)(ck + (size_t)i * 8)), b2 = __builtin_nontemporal_load((const f32x4*)(ck + (size_t)i * 8 + 4));
            u32x4 o; o.x = pk2(a[0], a[1]); o.y = pk2(a[2], a[3]); o.z = pk2(b2[0], b2[1]); o.w = pk2(b2[2], b2[3]);
            *(u32x4*)(Ks + ((size_t)bhm * 2560 + 2048 + s) * 64 + c * 8) = o;
        }
        const float* cv = P->in[3]; bf16* VTs = (bf16*)(ws + WS_VTS);
        for (int i = gt; i < 262144; i += NGT) {
            const int sc = ((i >> 10) & 7) * 8 + (i & 7), dv = (i >> 3) & 127, bh = i >> 13;
            const float* src = cv + ((size_t)bh * 512 + sc * 8) * 128 + dv;
            float v8[8];
#pragma unroll
            for (int j = 0; j < 8; ++j) v8[j] = __builtin_nontemporal_load(src + 128 * j);
            asm volatile("" ::: "memory");
            u32x4 o; o.x = pk2(v8[0], v8[1]); o.y = pk2(v8[2], v8[3]); o.z = pk2(v8[4], v8[5]); o.w = pk2(v8[6], v8[7]);
            *(u32x4*)(VTs + ((size_t)bh * 128 + dv) * 2560 + 2048 + sc * 8) = o;
        }
    }
    {
        LAS float* scr = (LAS float*)(lds + wave * 16384);
        const int gw = rank * 8 + wave, NGW = nblk * 8;
        const int I1 = (what & 2) ? 16 * 80 : 0, I2 = (what & 4) ? 16 * 32 : 0, I3 = (what & 8) ? 16 * 176 : 0, I4 = (what & 16) ? 44 * 32 : 0, NITEMS = I1 + I2 + I3 + I4;
        for (int it = gw; it < NITEMS; it += NGW) {
            int r = it;
            if (r < I1) { p0_transpose_item<1>(P->in[10], 1024, NIN, (bf16*)(ws + WS_W1T), scr, r, lane); continue; } r -= I1;
            if (r < I2) { p0_transpose_item<0>(P->in[22], 1024, 1024, (bf16*)(ws + WS_W2T), scr, r, lane); continue; } r -= I2;
            if (r < I3) { p0_transpose_item<2>(P->in[23], 1024, 2 * DFF, (bf16*)(ws + WS_W3T), scr, r, lane); continue; } r -= I3;
            p0_transpose_item<0>(P->in[24], DFF, 1024, (bf16*)(ws + WS_W4T), scr, r, lane);
        }
    }
}

template <bool BF>
__device__ __forceinline__ void norm_phase(const float* xp, const float* xs, const float* g, const float* mods, int shift_off, int scale_off, bf16* XM, int lane, int wave) {
    const int gw = blockIdx.x * 8 + wave, NGW = gridDim.x * 8;
    constexpr int R = 3;
    for (int m0 = gw * R; m0 < NTOK; m0 += NGW * R) {
        f32x4 v[R][4];
#pragma unroll
        for (int rr = 0; rr < R; ++rr) { const int m = m0 + rr;
            if (BF) {
                const u32x2* xr = (const u32x2*)((const bf16*)xp + (size_t)m * DM) + lane;
#pragma unroll
                for (int j = 0; j < 4; ++j) { const u32x2 w = __builtin_nontemporal_load(xr + 64 * j);
                    v[rr][j] = (f32x4){__uint_as_float(w.x << 16), __uint_as_float(w.x & 0xffff0000u), __uint_as_float(w.y << 16), __uint_as_float(w.y & 0xffff0000u)}; }
            } else {
                const float* xrow = m < NPROMPT ? xp + (size_t)m * DM : xs + (size_t)(m - NPROMPT) * DM;
                const f32x4* xr = (const f32x4*)xrow + lane;
#pragma unroll
                for (int j = 0; j < 4; ++j) v[rr][j] = __builtin_nontemporal_load(xr + 64 * j);
            } }
#pragma unroll
        for (int rr = 0; rr < R; ++rr) { const int m = m0 + rr;
            const int cond = m < NPROMPT ? 0 : 1 + ((m - NPROMPT) >> 11);
            float s = 0.f;
#pragma unroll
            for (int j = 0; j < 4; ++j) { const f32x4 q = v[rr][j] * v[rr][j]; s += (q[0] + q[1]) + (q[2] + q[3]); }
            const float rstd = rsqrtf(wave_sum(s) * (1.0f / DM) + 1e-6f);
            const float* sh = mods + cond * 6144 + shift_off; const float* sc = mods + cond * 6144 + scale_off;
            u32x2* o8 = (u32x2*)(XM + (size_t)m * DM) + lane;
#pragma unroll
            for (int j = 0; j < 4; ++j) {
                const f32x4 gg = ((const f32x4*)g)[lane + 64 * j], s1 = ((const f32x4*)sc)[lane + 64 * j], h1 = ((const f32x4*)sh)[lane + 64 * j];
                const f32x4 y = v[rr][j] * rstd * gg * (1.0f + s1) + h1;
                u32x2 w; w.x = pk2(y[0], y[1]); w.y = pk2(y[2], y[3]); o8[64 * j] = w;
            }
        }
    }
}

__device__ __forceinline__ void sgu_phase(KP P, LAS unsigned char* lds, int tid, int lane, int wave) {
    unsigned char* ws = P->ws;
    const float* ssq = (const float*)(ws + WS_SSQ);
    const bf16* U = (const bf16*)(ws + WS_U);
    bf16* MIX = (bf16*)(ws + WS_XM);
    const float* sng = P->in[18]; const float* sw = P->in[19]; const float* sb = P->in[20]; const float* mog = P->in[21];
    const int r = lane & 31, h = lane >> 5, pb = wave & 3, ch2 = wave >> 2;
    constexpr int TP = 272;
    LAS unsigned char* A = lds;
    LAS unsigned char* B = lds + 32768;
    LAS unsigned char* UT = lds + 65536;
    LAS unsigned char* OT = lds + 65536 + 128 * TP;
    LAS float* red = (LAS float*)(lds + 65536 + 256 * TP);
    LAS float* rsq = red + 256;
    LAS float* rstv = rsq + 512;
    for (int ck = blockIdx.x; ck < 192; ck += gridDim.x) {
        const bool prompt = ck < 64;
        const int b = prompt ? (ck >> 1) : ((ck - 64) >> 4), s0 = prompt ? ((ck & 1) << 7) : (((ck - 64) & 15) << 7), Sx = prompt ? 256 : 2048;
        const bf16* GVT = prompt ? (const bf16*)(ws + WS_GVTP) : (const bf16*)(ws + WS_GVTS);
        const int tok0 = ck * 128;
        __syncthreads();
        { const int q = tid >> 2, g = tid & 3; rsq[g * 128 + q] = rsqrtf(ssq[(size_t)(tok0 + q) * 4 + g] * (1.0f / 128.0f) + 1e-6f); }
        const int p = pb * 32 + r;
        float ss = 0.f;
#pragma unroll 1
        for (int g = 0; g < 4; ++g) {
            __syncthreads();
#pragma unroll
            for (int i = 0; i < 4; ++i) { const int q = tid + 512 * i, c = q >> 4, cc = q & 15;
                const u32x4 v = __builtin_nontemporal_load((const u32x4*)(GVT + ((size_t)b * 512 + g * 128 + c) * Sx + s0 + cc * 8));
                const u32x4 uu = __builtin_nontemporal_load((const u32x4*)(U + (size_t)(tok0 + c) * 512 + g * 128 + cc * 8));
                *(LAS u32x4*)(A + c * 256 + ((cc ^ (c & 15)) << 4)) = v;
                *(LAS u32x4*)(UT + c * TP + cc * 16) = uu; }
            asm volatile("" ::: "memory");
#pragma unroll
            for (int i = 0; i < 8; ++i) { const int idx = tid + 512 * i, pp = idx >> 5, q4 = (idx & 31) << 2;
                const f32x4 w = *(const f32x4*)(sw + (size_t)g * 16384 + pp * 128 + q4);
                const f32x4 rs = *(const LAS f32x4*)(rsq + g * 128 + q4);
                const f32x4 y = w * rs; u32x2 o; o.x = pk2(y[0], y[1]); o.y = pk2(y[2], y[3]);
                const int cc = q4 >> 3;
                *(LAS u32x2*)(B + pp * 256 + ((cc ^ (pp & 15)) << 4) + ((q4 & 4) << 1)) = o;
                if (i == 3) asm volatile("" ::: "memory"); }
            __syncthreads();
            f32x16 acc[2]; acc[0] = (f32x16)(0.f); acc[1] = (f32x16)(0.f);
#pragma unroll
            for (int ks = 0; ks < 8; ++ks) {
                const bf16x8 bw = *(const LAS bf16x8*)(B + p * 256 + (((2 * ks + h) ^ (p & 15)) << 4));
#pragma unroll
                for (int t = 0; t < 2; ++t) { const int crow = (ch2 * 2 + t) * 32 + r;
                    const bf16x8 ag = *(const LAS bf16x8*)(A + crow * 256 + (((2 * ks + h) ^ (crow & 15)) << 4));
                    acc[t] = __builtin_amdgcn_mfma_f32_32x32x16_bf16(ag, bw, acc[t], 0, 0, 0); }
            }
            const float bp = sb[g * 128 + p];
#pragma unroll
            for (int t = 0; t < 2; ++t)
#pragma unroll
                for (int q = 0; q < 4; ++q) {
                    const int c = (ch2 * 2 + t) * 32 + 8 * q + 4 * h;
                    const f32x4 gn = *(const f32x4*)(sng + g * 128 + c);
                    const u32x2 uu = *(const LAS u32x2*)(UT + p * TP + c * 2);
                    float uf[4]; uf[0] = __uint_as_float(uu.x << 16); uf[1] = __uint_as_float(uu.x & 0xffff0000u); uf[2] = __uint_as_float(uu.y << 16); uf[3] = __uint_as_float(uu.y & 0xffff0000u);
                    float v[4];
#pragma unroll
                    for (int j = 0; j < 4; ++j) { v[j] = uf[j] * fmaf(gn[j], acc[t][4 * q + j], bp); ss = fmaf(v[j], v[j], ss); }
                    u32x2 o; o.x = pk2(v[0], v[1]); o.y = pk2(v[2], v[3]);
                    *(LAS u32x2*)(OT + p * TP + c * 2) = o;
                }
            __syncthreads();
#pragma unroll
            for (int i = 0; i < 4; ++i) { const int q = tid + 512 * i, row = q >> 4, cc = q & 15;
                *(u32x4*)(MIX + (size_t)(tok0 + row) * 1024 + 512 + g * 128 + cc * 8) = *(const LAS u32x4*)(OT + row * TP + cc * 16); }
        }
        ss += __shfl_xor(ss, 32);
        if (h == 0) red[ch2 * 128 + p] = ss;
        __syncthreads();
        if (tid < 128) rstv[tid] = rsqrtf((red[tid] + red[128 + tid]) * (1.0f / 512.0f) + 1e-6f);
        __syncthreads();
#pragma unroll 4
        for (int i = 0; i < 16; ++i) { const int q = tid + 512 * i, row = q >> 6, cc = q & 63;
            u32x4* mp = (u32x4*)(MIX + (size_t)(tok0 + row) * 1024 + 512 + cc * 8);
            const u32x4 x = *mp; const float rs = rstv[row];
            const f32x4 m0 = *(const f32x4*)(mog + cc * 8), m1 = *(const f32x4*)(mog + cc * 8 + 4);
            u32x4 o;
            o.x = pk2(__uint_as_float(x.x << 16) * rs * m0[0], __uint_as_float(x.x & 0xffff0000u) * rs * m0[1]);
            o.y = pk2(__uint_as_float(x.y << 16) * rs * m0[2], __uint_as_float(x.y & 0xffff0000u) * rs * m0[3]);
            o.z = pk2(__uint_as_float(x.z << 16) * rs * m1[0], __uint_as_float(x.z & 0xffff0000u) * rs * m1[1]);
            o.w = pk2(__uint_as_float(x.w << 16) * rs * m1[2], __uint_as_float(x.w & 0xffff0000u) * rs * m1[3]);
            *mp = o; }
    }
    __syncthreads();
}

__device__ __forceinline__ float max3f(float a, float b, float c) { float r; asm("v_max3_f32 %0, %1, %2, %3" : "=v"(r) : "v"(a), "v"(b), "v"(c)); return r; }
__device__ __forceinline__ void attn_unit(LAS unsigned char* lds, const bf16* Qb, int Sq, int q0, const bf16* Kb, const bf16* VTb, int Sk,
                                          bf16* mixp, const float* gout, float lam, int tid, int lane, int wave, int tmul = 1) {
    const int r = lane & 31, h = lane >> 5, qsub = wave >> 1, map = wave & 1;
    const int nt = Sk >> 6;
    bf16x8 qf[4];
    { const bf16* qp = Qb + ((size_t)map * Sq + q0 + qsub * 32 + r) * 64 + 8 * h;
#pragma unroll
      for (int ks = 0; ks < 4; ++ks) qf[ks] = *(const bf16x8*)(qp + 16 * ks); }
    const bf16* K1 = Kb; const bf16* K2 = Kb + (size_t)Sk * 64;
    const int srow = tid >> 3, sc = tid & 7;
    const int so = srow * 128 + ((sc ^ ((srow >> 1) & 7)) << 4);
    const bf16* gk1 = K1 + tid * 8; const bf16* gk2 = K2 + tid * 8;
    const bf16* gv0 = VTb + (size_t)srow * Sk + sc * 8; const bf16* gv1 = gv0 + (size_t)64 * Sk;
    const int kr = (r & 19) | ((r & 4) << 1) | ((r & 8) >> 1);
    const int kx = (h ^ ((kr >> 1) & 7)) << 4, koff = map * 8192 + kr * 128;
    const int vx = (h ^ ((r >> 1) & 7)) << 4, voff = 16384 + r * 128;
    f32x16 O[4];
#pragma unroll
    for (int i = 0; i < 4; ++i) O[i] = (f32x16)(0.f);
    float mrun = -1e30f, lsum = 0.f;
    const float C = 0.18033688011112042f;
    const float TLAZY = 8.0f / 0.18033688011112042f;
    u32x4 st0, st1, st2, st3;
    st0 = *(const u32x4*)gk1; st1 = *(const u32x4*)gk2; st2 = *(const u32x4*)gv0; st3 = *(const u32x4*)gv1;
    *(LAS u32x4*)(lds + so) = st0; *(LAS u32x4*)(lds + 8192 + so) = st1; *(LAS u32x4*)(lds + 16384 + so) = st2; *(LAS u32x4*)(lds + 24576 + so) = st3;
    __syncthreads();
    for (int t = 0; t < nt; ++t) {
        LAS unsigned char* buf = lds + ((t & 1) << 15);
        const bool p1 = t + 1 < nt;
        if (p1) { const int e = (t + 1) * tmul * 64;
            st0 = *(const u32x4*)(gk1 + (size_t)e * 64); st1 = *(const u32x4*)(gk2 + (size_t)e * 64); st2 = *(const u32x4*)(gv0 + e); st3 = *(const u32x4*)(gv1 + e); }
        bf16x8 fa[8], fb[8];
#pragma unroll
        for (int ks = 0; ks < 4; ++ks) { const int co = ((2 * ks) << 4) ^ kx; fa[2 * ks] = *(const LAS bf16x8*)(buf + koff + co); fa[2 * ks + 1] = *(const LAS bf16x8*)(buf + koff + 4096 + co); }
        __builtin_amdgcn_sched_barrier(0);
        f32x16 S0 = (f32x16)(0.f), S1 = (f32x16)(0.f);
#pragma unroll
        for (int ks = 0; ks < 4; ++ks) { S0 = __builtin_amdgcn_mfma_f32_32x32x16_bf16(fa[2 * ks], qf[ks], S0, 0, 0, 0); S1 = __builtin_amdgcn_mfma_f32_32x32x16_bf16(fa[2 * ks + 1], qf[ks], S1, 0, 0, 0); }
#pragma unroll
        for (int kk = 0; kk < 2; ++kk) { const int co = ((2 * kk) << 4) ^ vx;
#pragma unroll
            for (int d = 0; d < 4; ++d) fb[kk * 4 + d] = *(const LAS bf16x8*)(buf + voff + d * 4096 + co); }
        __builtin_amdgcn_sched_barrier(0);
        float mx; { float m0 = max3f(S0[0], S0[1], S0[2]), m1 = max3f(S0[3], S0[4], S0[5]), m2 = max3f(S0[6], S0[7], S0[8]), m3 = max3f(S0[9], S0[10], S0[11]);
            float m4 = max3f(S0[12], S0[13], S0[14]), m5 = max3f(S0[15], S1[0], S1[1]), m6 = max3f(S1[2], S1[3], S1[4]), m7 = max3f(S1[5], S1[6], S1[7]);
            float m8 = max3f(S1[8], S1[9], S1[10]), m9 = max3f(S1[11], S1[12], S1[13]), m10 = max3f(S1[14], S1[15], m0);
            m1 = max3f(m1, m2, m3); m4 = max3f(m4, m5, m6); m7 = max3f(m7, m8, m9); mx = max3f(m1, m4, m7); mx = max3f(mx, m10, m10); }
        { const u32x2 sw2 = __builtin_amdgcn_permlane32_swap(__float_as_uint(mx), __float_as_uint(mx), false, false); mx = max3f(__uint_as_float(sw2.x), __uint_as_float(sw2.y), mx); }
        if (__builtin_amdgcn_ballot_w64(mx > mrun + TLAZY) != 0ull) {
            const float mnew = (mx > mrun + TLAZY) ? mx : mrun; const float alpha = __builtin_amdgcn_exp2f((mrun - mnew) * C);
            mrun = mnew; lsum *= alpha;
#pragma unroll
            for (int d = 0; d < 4; ++d) O[d] = O[d] * alpha; }
        { const float mc = mrun * C; S0 = S0 * C - mc; S1 = S1 * C - mc; }
#pragma unroll
        for (int i = 0; i < 16; ++i) { S0[i] = __builtin_amdgcn_exp2f(S0[i]); S1[i] = __builtin_amdgcn_exp2f(S1[i]); }
        { const f32x16 sv = S0 + S1;
          lsum += ((sv[0] + sv[1]) + (sv[2] + sv[3])) + ((sv[4] + sv[5]) + (sv[6] + sv[7])) + (((sv[8] + sv[9]) + (sv[10] + sv[11])) + ((sv[12] + sv[13]) + (sv[14] + sv[15]))); }
        bf16x8 pf[4];
#pragma unroll
        for (int s2 = 0; s2 < 2; ++s2) { u32x4 w0, w1;
            w0.x = pk2(S0[8 * s2 + 0], S0[8 * s2 + 1]); w0.y = pk2(S0[8 * s2 + 2], S0[8 * s2 + 3]); w0.z = pk2(S0[8 * s2 + 4], S0[8 * s2 + 5]); w0.w = pk2(S0[8 * s2 + 6], S0[8 * s2 + 7]);
            w1.x = pk2(S1[8 * s2 + 0], S1[8 * s2 + 1]); w1.y = pk2(S1[8 * s2 + 2], S1[8 * s2 + 3]); w1.z = pk2(S1[8 * s2 + 4], S1[8 * s2 + 5]); w1.w = pk2(S1[8 * s2 + 6], S1[8 * s2 + 7]);
            pf[s2] = __builtin_bit_cast(bf16x8, w0); pf[2 + s2] = __builtin_bit_cast(bf16x8, w1); }
        __builtin_amdgcn_sched_barrier(0);
#pragma unroll
        for (int kk = 2; kk < 4; ++kk) { const int co = ((2 * kk) << 4) ^ vx;
#pragma unroll
            for (int d = 0; d < 4; ++d) fa[(kk - 2) * 4 + d] = *(const LAS bf16x8*)(buf + voff + d * 4096 + co); }
        __builtin_amdgcn_sched_barrier(0);
#pragma unroll
        for (int kk = 0; kk < 2; ++kk)
#pragma unroll
            for (int d = 0; d < 4; ++d) O[d] = __builtin_amdgcn_mfma_f32_32x32x16_bf16(fb[kk * 4 + d], pf[kk], O[d], 0, 0, 0);
#pragma unroll
        for (int kk = 2; kk < 4; ++kk)
#pragma unroll
            for (int d = 0; d < 4; ++d) O[d] = __builtin_amdgcn_mfma_f32_32x32x16_bf16(fa[(kk - 2) * 4 + d], pf[kk], O[d], 0, 0, 0);
        if (p1) { LAS unsigned char* nb = lds + (((t + 1) & 1) << 15);
            *(LAS u32x4*)(nb + so) = st0; *(LAS u32x4*)(nb + 8192 + so) = st1; *(LAS u32x4*)(nb + 16384 + so) = st2; *(LAS u32x4*)(nb + 24576 + so) = st3; }
        __syncthreads();
    }
    const float l = lsum + __shfl_xor(lsum, 32);
    LAS float* comb = (LAS float*)(lds + 65536 + qsub * 16384);
    if (map == 1) {
        const float f = lam / l;
#pragma unroll
        for (int d = 0; d < 4; ++d)
#pragma unroll
            for (int i = 0; i < 16; ++i) comb[(d * 16 + i) * 64 + lane] = O[d][i] * f;
    }
    __syncthreads();
    if (map == 0) {
        const float inv = 1.0f / l; float ss = 0.f;
#pragma unroll
        for (int d = 0; d < 4; ++d)
#pragma unroll
            for (int i = 0; i < 16; ++i) { const float o = fmaf(O[d][i], inv, -comb[(d * 16 + i) * 64 + lane]); O[d][i] = o; ss = fmaf(o, o, ss); }
        ss += __shfl_xor(ss, 32);
        const float rs = rsqrtf(ss * (1.0f / 128.0f) + 1e-6f) * 0.8f;
        int r2 = r; asm volatile("" : "+v"(r2));
        LAS unsigned char* ot = lds + (qsub * 32 + r2) * 272;
#pragma unroll
        for (int d = 0; d < 4; ++d)
#pragma unroll
            for (int q = 0; q < 4; ++q) {
                const int dv = 32 * d + 8 * q + 4 * h;
                const f32x4 gg = *(const f32x4*)(gout + dv);
                u32x2 o; o.x = pk2(O[d][4 * q] * rs * gg[0], O[d][4 * q + 1] * rs * gg[1]); o.y = pk2(O[d][4 * q + 2] * rs * gg[2], O[d][4 * q + 3] * rs * gg[3]);
                *(LAS u32x2*)(ot + dv * 2) = o;
                if (q & 1) asm volatile("" ::: "memory");
            }
    }
    __syncthreads();
    int t2 = tid; asm volatile("" : "+v"(t2));
#pragma unroll
    for (int i = 0; i < 4; ++i) { const int q = t2 + 512 * i, row = q >> 4, cc = q & 15;
        *(u32x4*)(mixp + (size_t)row * 1024 + cc * 8) = *(const LAS u32x4*)(lds + row * 272 + cc * 16); }
    __syncthreads();
}

__device__ __forceinline__ void attn_phase(KP P, LAS unsigned char* lds, int tid, int lane, int wave, bool shadow = false, int tmul = 1) {
    unsigned char* ws = P->ws;
    const float d1 = wave_sum(P->in[13][lane] * P->in[14][lane]), d2 = wave_sum(P->in[15][lane] * P->in[16][lane]);
    const float lam = __expf(d1) - __expf(d2) + 0.2f;
    bf16* MIX = shadow ? (bf16*)(ws + 206 * MiB) : (bf16*)(ws + WS_XM);
    const float* aog = P->in[17];
    const int G = gridDim.x, bx = blockIdx.x;
    const int n_items = (G == 256) ? (bx >= 192 ? 6 : 2) : 0;
    for (int it = 0, j = bx; (G == 256) ? (it < n_items) : (j < 768); ++it, j += G) {
        int jj = j;
        if (G == 256) jj = it < 2 ? bx + 256 * it : 512 + (bx - 192) * 4 + (it - 2);
        if (jj < 512) {
            const int x = jj & 7, idx = jj >> 3, grp = x * 4 + (idx >> 4), qb = idx & 15, b = grp >> 2, hh = grp & 3;
            attn_unit(lds, (const bf16*)(ws + WS_QS) + (size_t)(b * 4 + hh) * 2 * 2048 * 64, 2048, qb * 128,
                      (const bf16*)(ws + WS_KS) + (size_t)(b * 4 + hh) * 2 * 2560 * 64, (const bf16*)(ws + WS_VTS) + ((size_t)b * 512 + hh * 128) * 2560, 2560,
                      MIX + ((size_t)NPROMPT + b * 2048 + qb * 128) * 1024 + hh * 128, aog + hh * 128, lam, tid, lane, wave, tmul);
        } else {
            const int k = jj - 512, grp = k >> 1, qb = k & 1, b = grp >> 2, hh = grp & 3;
            attn_unit(lds, (const bf16*)(ws + WS_QP) + (size_t)(b * 4 + hh) * 2 * 256 * 64, 256, qb * 128,
                      (const bf16*)(ws + WS_KP) + (size_t)(b * 4 + hh) * 2 * 256 * 64, (const bf16*)(ws + WS_VTP) + ((size_t)b * 512 + hh * 128) * 256, 256,
                      MIX + ((size_t)b * 256 + qb * 128) * 1024 + hh * 128, aog + hh * 128, lam, tid, lane, wave, tmul);
        }
    }
}

#define RLX_AGENT __ATOMIC_RELAXED, __HIP_MEMORY_SCOPE_AGENT
#define XB_TMO      128
#define XB_XCNT(j)  (256  + 64 * (j))
#define XB_XSUB(j)  (1280 + 64 * (j))
#define XB_XGEN(j)  (2304 + 64 * (j))
#define XB_TOP      3328
#define XB_TOPGEN   3392
#define XCD_BAR_WORDS 3456
#define XB_SPIN_CAP (1u << 18)

__device__ __forceinline__ unsigned xb_ld(unsigned* p)              { return __hip_atomic_load(p, __ATOMIC_RELAXED, __HIP_MEMORY_SCOPE_AGENT); }
__device__ __forceinline__ unsigned xb_add(unsigned* p, unsigned v) { return __hip_atomic_fetch_add(p, v, __ATOMIC_RELAXED, __HIP_MEMORY_SCOPE_AGENT); }
__device__ __forceinline__ unsigned xb_xcc_id() { return (unsigned)__builtin_amdgcn_s_getreg((3 << 11) | 20) & 0xFu; }
#define XB_SPIN(cond, bar) do { unsigned _sp = 0; while (cond) { __builtin_amdgcn_s_sleep(1); \
    if ((++_sp & 255u) == 0u) { if (xb_ld(&(bar)[XB_TMO])) break; if (_sp > XB_SPIN_CAP) { atomicAdd(&(bar)[XB_TMO], 1u); break; } } } } while (0)

struct XcdBarrier {
    unsigned* bar; unsigned x;
    volatile LAS unsigned* st;
};

__device__ __forceinline__ XcdBarrier xcd_barrier_post(unsigned* bar, volatile LAS unsigned* st) {
    XcdBarrier b; b.bar = bar; b.x = xb_xcc_id(); b.st = st;
    if (threadIdx.x == 0) (void)xb_add(&bar[XB_XCNT(b.x)], 1u);
    return b;
}
__device__ __forceinline__ void xcd_barrier_complete(unsigned* bar, unsigned x, unsigned& nloc, unsigned& nx) {
    const unsigned G = gridDim.x * gridDim.y * gridDim.z;
    unsigned sum, cnt, mine, sp = 0u;
    for (;;) {
        sum = 0u; cnt = 0u; mine = 0u;
#pragma unroll
        for (unsigned j = 0; j < 16; ++j) { const unsigned c = xb_ld(&bar[XB_XCNT(j)]); sum += c; cnt += (c > 0u) ? 1u : 0u; mine = (j == x) ? c : mine; }
        if (sum == G) break;
        __builtin_amdgcn_s_sleep(1);
        if ((++sp & 255u) == 0u) { if (xb_ld(&bar[XB_TMO])) break; if (sp > XB_SPIN_CAP) { atomicAdd(&bar[XB_TMO], 1u); break; } }
    }
    nloc = mine > 0u ? mine : 1u; nx = cnt > 0u ? cnt : 1u;
}

__device__ __forceinline__ void xcd_barrier(const XcdBarrier& b) {
    asm volatile("s_waitcnt vmcnt(0)" ::: "memory");
    __syncthreads();
    if (threadIdx.x == 0) {
        unsigned* bar = b.bar;
        __builtin_amdgcn_s_waitcnt(0);
        unsigned nloc = b.st[0], nx = b.st[1];
        if (nloc == 0u) { xcd_barrier_complete(bar, b.x, nloc, nx); b.st[0] = nloc; b.st[1] = nx; }
        const unsigned old = xb_add(&bar[XB_XSUB(b.x)], 1u);
        const unsigned gen = old / nloc;
        if (old + 1u == (gen + 1u) * nloc) {
            __builtin_amdgcn_fence(__ATOMIC_RELEASE, "agent");
            asm volatile("s_waitcnt vmcnt(0)" ::: "memory");
            const unsigned og = xb_add(&bar[XB_TOP], 1u);
            const unsigned tg = og / nx;
            if (og + 1u == (tg + 1u) * nx) xb_add(&bar[XB_TOPGEN], 1u);
            else XB_SPIN(xb_ld(&bar[XB_TOPGEN]) == tg, bar);
            __builtin_amdgcn_fence(__ATOMIC_ACQUIRE, "agent");
            xb_add(&bar[XB_XGEN(b.x)], 1u);
            asm volatile("s_waitcnt vmcnt(0)" ::: "memory");
        } else {
            XB_SPIN(xb_ld(&bar[XB_XGEN(b.x)]) == gen, bar);
            __builtin_amdgcn_fence(__ATOMIC_ACQUIRE, "agent");
            asm volatile("s_waitcnt vmcnt(0)" ::: "memory");
        }
    }
    __syncthreads();
}

__global__ void __launch_bounds__(512, 2) fwd_megakernel(Params Parg) {
    extern __shared__ __attribute__((aligned(16))) unsigned char lds_raw[];
    LAS unsigned char* lds = (LAS unsigned char*)lds_raw;
    const int tid = threadIdx.x, lane = tid & 63, wave = __builtin_amdgcn_readfirstlane(tid >> 6);
    int lo, hi; XcdBarrier xbar;
    { KP P = kargs(); lo = P->ph_lo; hi = P->ph_hi;
      volatile LAS unsigned* bst = (volatile LAS unsigned*)(lds + 147456);
      if (tid == 0) { bst[0] = 0u; bst[1] = 0u; }
      __syncthreads();
      xbar = xcd_barrier_post((unsigned*)(P->ws + WS_BAR), bst); }
#define IN(k) (lo <= (k) && (k) < hi)
#define SEAM(k) do { if (IN(k) && IN((k) + 1)) { xcd_barrier(xbar); } } while (0)
    if (hi > NPHASE + 1) cg::this_grid().sync();
    if (IN(0)) { KP P = kargs(); p0_ada(P, lds, tid, lane, wave); }
    SEAM(0);
    const bool defer = gridDim.x == 256;
    if (IN(1)) { KP P = kargs(); convert_job(P, lds, tid, lane, wave, defer ? 2 : 31, (int)blockIdx.x, (int)gridDim.x); }
    if (IN(1)) { KP P = kargs(); unsigned char* ws = P->ws; norm_phase<false>(P->in[0], P->in[1], P->in[6], (const float*)(ws + WS_MODS), 0, 1024, (bf16*)(ws + WS_XM), lane, wave); }
    SEAM(1);
    if (IN(2)) {
        KP P = kargs(); unsigned char* ws = P->ws;
        pg8::Gemm g{(const bf16*)(ws + WS_XM), (const bf16*)(ws + WS_W1T), NTOK, NIN, 1024}; pg8::StaticOrder S; S.init(NTOK, NIN, (int)gridDim.x, (int)blockIdx.x);
        pg8::EpiIn E{ws, P->out, P->in[11], P->in[12]};
        pg8::gemm_phase<pg8::EpiIn, pg8::StaticOrder, true, true>(lds, g, S, E);
    }
    if (IN(2) && defer && blockIdx.x >= 192) { KP P = kargs(); convert_job(P, lds, tid, lane, wave, 1 | 4, (int)blockIdx.x - 192, 64); }
    SEAM(2);
    if (IN(3)) { KP P = kargs(); sgu_phase(P, lds, tid, lane, wave); attn_phase(P, lds, tid, lane, wave); }
    SEAM(3);
    const bool fuse_n2 = gridDim.x == 256;
    if (IN(4)) {
        KP P = kargs(); unsigned char* ws = P->ws;
        pg8::Gemm g{(const bf16*)(ws + WS_XM), (const bf16*)(ws + WS_W2T), NTOK, 1024, 1024};
        if (fuse_n2) {
            pg8::PanelOrder S; S.init((int)blockIdx.x);
            pg8::EpiRes1N E{P->in[0], P->in[1], (bf16*)(ws + WS_X1B), (bf16*)(ws + WS_XM2), (const float*)(ws + WS_MODS), P->in[7], (float*)(ws + WS_XBUF), (unsigned*)(ws + WS_CNT), lds + 131072};
            pg8::gemm_phase<pg8::EpiRes1N, pg8::PanelOrder, true, true>(lds, g, S, E);
        } else {
            pg8::StaticOrder S; S.init(NTOK, 1024, (int)gridDim.x, (int)blockIdx.x);
            pg8::EpiRes1 E{P->in[0], P->in[1], (bf16*)(ws + WS_X1B), (const float*)(ws + WS_MODS) + 2048};
            pg8::gemm_phase<pg8::EpiRes1, pg8::StaticOrder, true, true>(lds, g, S, E);
        }
    }
    if (IN(4) && defer && blockIdx.x >= 128) { KP P = kargs(); convert_job(P, lds, tid, lane, wave, 8 | 16, (int)blockIdx.x - 128, 128); }
    if (!fuse_n2) SEAM(4);
    if (IN(5) && !fuse_n2) { KP P = kargs(); unsigned char* ws = P->ws; norm_phase<true>((const float*)(ws + WS_X1B), nullptr, P->in[7], (const float*)(ws + WS_MODS), 3072, 4096, (bf16*)(ws + WS_XM2), lane, wave); }
    SEAM(5);
    if (IN(6)) {
        KP P = kargs(); unsigned char* ws = P->ws;
        pg8::Gemm g{(const bf16*)(ws + WS_XM2), (const bf16*)(ws + WS_W3T), NTOK, 2 * DFF, 1024}; pg8::StaticOrder S; S.init(NTOK, 2 * DFF, (int)gridDim.x, (int)blockIdx.x);
        pg8::EpiSwiglu E{(bf16*)(ws + WS_HID)};
        pg8::gemm_phase<pg8::EpiSwiglu, pg8::StaticOrder, true, true>(lds, g, S, E);
    }
    SEAM(6);
    if (IN(7)) {
        KP P = kargs(); unsigned char* ws = P->ws; float* out = P->out;
        pg8::Gemm g{(const bf16*)(ws + WS_HID), (const bf16*)(ws + WS_W4T), NTOK, 1024, DFF}; pg8::StaticOrder S; S.init(NTOK, 1024, (int)gridDim.x, (int)blockIdx.x);
        pg8::EpiRes2 E{(const bf16*)(ws + WS_X1B), out + OUT_Y, (const float*)(ws + WS_MODS) + 5120};
        pg8::gemm_phase<pg8::EpiRes2, pg8::StaticOrder, true, true>(lds, g, S, E);
    }
#undef IN
#undef SEAM
}

extern "C" void kernel_launch(void* const* d_in, const int* in_sizes, int n_in, void* d_out, int out_size, void* d_ws, size_t ws_size, hipStream_t stream) {
    static int grid = 0;
    if (grid == 0) {
        if (n_in != 25 || ws_size < WS_END) { fprintf(stderr, "kernel_launch: built for 25 inputs and >= %zu bytes of workspace; got %d, %zu\n", (size_t)WS_END, n_in, ws_size); grid = -1; return; }
        int dev = 0, cus = 0, per_cu = 0;
        if (hipGetDevice(&dev) != hipSuccess || hipDeviceGetAttribute(&cus, hipDeviceAttributeMultiprocessorCount, dev) != hipSuccess) { grid = -1; return; }
        if (hipFuncSetAttribute((const void*)fwd_megakernel, hipFuncAttributeMaxDynamicSharedMemorySize, LDS_BYTES) != hipSuccess) { fprintf(stderr, "kernel_launch: hipFuncSetAttribute failed\n"); grid = -1; return; }
        if (hipOccupancyMaxActiveBlocksPerMultiprocessor(&per_cu, (const void*)fwd_megakernel, 512, LDS_BYTES) != hipSuccess || per_cu < 1) { fprintf(stderr, "kernel_launch: occupancy query says %d\n", per_cu); per_cu = 1; }
        (void)hipGetLastError();
        grid = cus * per_cu;
    }
    if (grid < 0) return;
    if (hipMemsetAsync((char*)d_ws + WS_BAR, 0, 40 * 1024, stream) != hipSuccess) { fprintf(stderr, "kernel_launch: hipMemsetAsync failed\n"); return; }
    Params p{};
    for (int i = 0; i < 25; ++i) p.in[i] = (const float*)d_in[i];
    p.out = (float*)d_out; p.ws = (unsigned char*)d_ws;
#if MK_N_LAUNCHES == 1
    p.ph_lo = 0; p.ph_hi = NPHASE;
    void* args[] = {&p};
    hipError_t e = hipLaunchCooperativeKernel((const void*)fwd_megakernel, dim3(grid), dim3(512), args, LDS_BYTES, stream);
    if (e != hipSuccess) fprintf(stderr, "kernel_launch: cooperative launch failed: %s (grid %d)\n", hipGetErrorString(e), grid);
#else
    for (int k = 0; k < NPHASE; ++k) {
        p.ph_lo = k; p.ph_hi = k + 1;
        hipLaunchKernelGGL(fwd_megakernel, dim3(grid), dim3(512), LDS_BYTES, stream, p);
    }
#endif
}
```
